# Optimizing an MI355X kernel written in HIP

```python
import math
import jax, jax.numpy as jnp
from jax import lax
import numpy as np

D_MODEL = 1024
BATCH = 2
SEQ = 8192
DEPTH = 1
DEC_BATCH = 128
DEC_SEQ = 4
PAST_LEN = 16384
PAGE_SIZE = 128

HEAD_DIM = 64
N_HEADS = D_MODEL // 128
N_KV_HEADS = N_HEADS // 4
GQA_GROUP = N_HEADS // N_KV_HEADS
WINDOW = 128
ATTN_WIDTH = N_HEADS * HEAD_DIM
KV_WIDTH = N_KV_HEADS * HEAD_DIM
ROPE_THETA = 10000.0
SSM_WIDTH = D_MODEL // 2
SSM_GROUP_CH = 16
SSM_GROUPS = SSM_WIDTH // SSM_GROUP_CH
SSM_STATE = 64
D_FF = ((8 * D_MODEL // 3 + 127) // 128) * 128
IN_COLS = ATTN_WIDTH + 2 * KV_WIDTH + SSM_WIDTH + 2 * D_MODEL
SPLIT_POINTS = [ATTN_WIDTH, ATTN_WIDTH + KV_WIDTH, ATTN_WIDTH + 2 * KV_WIDTH,
                ATTN_WIDTH + 2 * KV_WIDTH + SSM_WIDTH,
                ATTN_WIDTH + 2 * KV_WIDTH + SSM_WIDTH + D_MODEL]
RMS_EPS = 1e-6
MASK_VALUE = -1e30

kernel_name = "macaron_griffin_swa_s5_decode_step"


def rms_norm(x, g):
    xf = x.astype(jnp.float32)
    y = xf * lax.rsqrt(jnp.mean(xf * xf, axis=-1, keepdims=True) + RMS_EPS) * g.astype(jnp.float32)
    return y.astype(x.dtype)


def swiglu(x, w1, w3, w2):
    return (jax.nn.silu(x @ w1) * (x @ w3)) @ w2


def rope(x, pos):
    half = HEAD_DIM // 2
    inv = ROPE_THETA ** (-2.0 * jnp.arange(half, dtype=jnp.float32) / HEAD_DIM)
    ang = pos[:, None] * inv[None, :]
    cos = jnp.cos(ang)[:, None, :]
    sin = jnp.sin(ang)[:, None, :]
    xf = x.astype(jnp.float32)
    x1, x2 = xf[..., :half], xf[..., half:]
    return jnp.concatenate([x1 * cos - x2 * sin, x2 * cos + x1 * sin], axis=-1).astype(x.dtype)


def sink_attend(scores, mask, sinks, v, av_eq):
    sink = sinks.astype(jnp.float32).reshape(N_KV_HEADS, GQA_GROUP, 1, 1)
    s = jnp.where(mask, scores, MASK_VALUE)
    m = jnp.maximum(jnp.max(s, axis=-1, keepdims=True), sink)
    p = jnp.exp(s - m)
    denom = jnp.sum(p, axis=-1, keepdims=True) + jnp.exp(sink - m)
    probs = (p / denom).astype(v.dtype)
    return jnp.einsum(av_eq, probs, v)


def swa_prompt(q, k, v, sinks):
    B, L = q.shape[:2]
    nb = L // WINDOW
    qb = q.reshape(B, nb, WINDOW, N_KV_HEADS, GQA_GROUP, HEAD_DIM)
    pad = ((0, 0), (WINDOW, 0), (0, 0), (0, 0))
    kp = jnp.pad(k, pad).reshape(B, nb + 1, WINDOW, N_KV_HEADS, HEAD_DIM)
    vp = jnp.pad(v, pad).reshape(B, nb + 1, WINDOW, N_KV_HEADS, HEAD_DIM)
    kb = jnp.concatenate([kp[:, :-1], kp[:, 1:]], axis=2)
    vb = jnp.concatenate([vp[:, :-1], vp[:, 1:]], axis=2)
    scores = jnp.einsum('bnqkgd,bnskd->bnkgqs', qb, kb).astype(jnp.float32)
    qi = jnp.arange(WINDOW)[:, None]
    sj = jnp.arange(2 * WINDOW)[None, :]
    diff = WINDOW + qi - sj
    kpos = (jnp.arange(nb)[:, None, None] - 1) * WINDOW + sj[None]
    mask = (diff >= 0)[None] & (diff < WINDOW)[None] & (kpos >= 0)
    mask = mask[None, :, None, None, :, :]
    out = sink_attend(scores, mask, sinks, vb, 'bnkgqs,bnskd->bnqkgd')
    return out.reshape(B, L, ATTN_WIDTH)


def swa_sample(q, k_new, v_new, k_buf, v_buf, sinks):
    B, T = q.shape[:2]
    kk = jnp.concatenate([k_buf.astype(k_new.dtype), k_new], axis=1)
    vv = jnp.concatenate([v_buf.astype(v_new.dtype), v_new], axis=1)
    qg = q.reshape(B, T, N_KV_HEADS, GQA_GROUP, HEAD_DIM)
    scores = jnp.einsum('btkgd,bskd->bkgts', qg, kk).astype(jnp.float32)
    diff = WINDOW + jnp.arange(T)[:, None] - jnp.arange(WINDOW + T)[None, :]
    mask = (diff >= 0) & (diff < WINDOW)
    out = sink_attend(scores, mask, sinks, vv, 'bkgts,bskd->btkgd')
    return out.reshape(B, T, ATTN_WIDTH), kk[:, T:], vv[:, T:]


def _ssm_combine(e1, e2):
    a1r, a1i, b1r, b1i = e1
    a2r, a2i, b2r, b2i = e2
    return (a2r * a1r - a2i * a1i,
            a2r * a1i + a2i * a1r,
            a2r * b1r - a2i * b1i + b2r,
            a2r * b1i + a2i * b1r + b2i)


def s5_scan(u, x0_re, x0_im, a_re, a_im, log_dt, b_re, b_im, c_re, c_im, d_skip):
    f32 = jnp.float32
    u = u.astype(f32)
    a_re, a_im = a_re.astype(f32), a_im.astype(f32)
    dt = jnp.exp(log_dt.astype(f32))[:, None]
    mag = jnp.exp(dt * a_re)
    ab_re, ab_im = mag * jnp.cos(dt * a_im), mag * jnp.sin(dt * a_im)
    den = a_re * a_re + a_im * a_im
    nr, ni = ab_re - 1.0, ab_im
    f_re = (nr * a_re + ni * a_im) / den
    f_im = (ni * a_re - nr * a_im) / den
    b_re, b_im = b_re.astype(f32), b_im.astype(f32)
    bb_re = f_re[..., None] * b_re - f_im[..., None] * b_im
    bb_im = f_re[..., None] * b_im + f_im[..., None] * b_re
    bu_re = jnp.einsum('btgc,gnc->btgn', u, bb_re)
    bu_im = jnp.einsum('btgc,gnc->btgn', u, bb_im)
    ar = jnp.broadcast_to(ab_re, bu_re.shape)
    ai = jnp.broadcast_to(ab_im, bu_re.shape)
    ac_re, ac_im, xs_re, xs_im = lax.associative_scan(_ssm_combine, (ar, ai, bu_re, bu_im), axis=1)
    if x0_re is not None:
        x0r = x0_re.astype(f32)[:, None]
        x0i = x0_im.astype(f32)[:, None]
        xs_re = xs_re + ac_re * x0r - ac_im * x0i
        xs_im = xs_im + ac_re * x0i + ac_im * x0r
    y = (jnp.einsum('btgn,gcn->btgc', xs_re, c_re.astype(f32))
         - jnp.einsum('btgn,gcn->btgc', xs_im, c_im.astype(f32))
         + d_skip.astype(f32) * u)
    return y, xs_re[:, -1], xs_im[:, -1]


def trunk_layer(x, pos0, k_buf, v_buf, s_re, s_im, p):
    B, T, _ = x.shape
    x = x + 0.5 * swiglu(rms_norm(x, p['ffn1_norm']), p['ffn1_w1'], p['ffn1_w3'], p['ffn1_w2'])
    h = rms_norm(x, p['mix_norm'])
    proj = h @ p['w_in']
    q, k, v, u, ga, gs = jnp.split(proj, SPLIT_POINTS, axis=-1)
    q = q.reshape(B, T, N_HEADS, HEAD_DIM)
    k = k.reshape(B, T, N_KV_HEADS, HEAD_DIM)
    v = v.reshape(B, T, N_KV_HEADS, HEAD_DIM)
    pos = (pos0 + jnp.arange(T)).astype(jnp.float32)
    q = rope(rms_norm(q, p['q_norm']), pos) * (HEAD_DIM ** -0.5)
    k = rope(rms_norm(k, p['k_norm']), pos)
    if k_buf is None:
        attn = swa_prompt(q, k, v, p['attn_sinks'])
        new_k, new_v = k[:, T - WINDOW:], v[:, T - WINDOW:]
    else:
        attn, new_k, new_v = swa_sample(q, k, v, k_buf, v_buf, p['attn_sinks'])
    y_ssm, new_re, new_im = s5_scan(u.reshape(B, T, SSM_GROUPS, SSM_GROUP_CH), s_re, s_im,
                                    p['ssm_a_re'], p['ssm_a_im'], p['ssm_log_dt'],
                                    p['ssm_b_re'], p['ssm_b_im'], p['ssm_c_re'], p['ssm_c_im'],
                                    p['ssm_d'])
    z = jax.nn.gelu(y_ssm.reshape(B, T, SSM_WIDTH).astype(x.dtype))
    ssm = z * jax.nn.sigmoid(z @ p['w_glu'] + p['b_glu'])
    merged = (jax.nn.sigmoid(ga) * (attn @ p['w_attn_out'])
              + jax.nn.sigmoid(gs) * (ssm @ p['w_ssm_out']))
    x = x + merged @ p['w_out']
    x = x + 0.5 * swiglu(rms_norm(x, p['ffn2_norm']), p['ffn2_w1'], p['ffn2_w3'], p['ffn2_w2'])
    return x, new_k, new_v, new_re, new_im


def setup_inputs(seed: int = 0) -> dict:
    key = jax.random.key(seed)
    ks = iter(jax.random.split(key, 48))
    f32 = jnp.float32

    def nrm(shape, scale):
        return jax.random.normal(next(ks), shape, f32) * scale

    L, D, G, N, CH = DEPTH, D_MODEL, SSM_GROUPS, SSM_STATE, SSM_GROUP_CH
    return {
        'x_prompt': nrm((BATCH, SEQ, D), 1.0),
        'x_sample': nrm((DEC_BATCH, DEC_SEQ, D), 1.0),
        'cache_k': nrm((L, DEC_BATCH, WINDOW, N_KV_HEADS, HEAD_DIM), 1.0),
        'cache_v': nrm((L, DEC_BATCH, WINDOW, N_KV_HEADS, HEAD_DIM), 1.0),
        'state_ssm_re': nrm((L, DEC_BATCH, G, N), 0.5),
        'state_ssm_im': nrm((L, DEC_BATCH, G, N), 0.5),
        'ffn1_norm': 1.0 + nrm((L, D), 0.02),
        'ffn1_w1': nrm((L, D, D_FF), D ** -0.5),
        'ffn1_w3': nrm((L, D, D_FF), D ** -0.5),
        'ffn1_w2': nrm((L, D_FF, D), D_FF ** -0.5),
        'mix_norm': 1.0 + nrm((L, D), 0.02),
        'w_in': nrm((L, D, IN_COLS), D ** -0.5),
        'q_norm': 1.0 + nrm((L, HEAD_DIM), 0.02),
        'k_norm': 1.0 + nrm((L, HEAD_DIM), 0.02),
        'attn_sinks': nrm((L, N_HEADS), 0.5),
        'w_attn_out': nrm((L, ATTN_WIDTH, D), ATTN_WIDTH ** -0.5),
        'ssm_a_re': -0.5 + nrm((L, G, N), 0.01),
        'ssm_a_im': math.pi * jnp.arange(N, dtype=f32) + nrm((L, G, N), 0.01),
        'ssm_log_dt': jax.random.uniform(next(ks), (L, G), f32, math.log(1e-3), math.log(1e-1)),
        'ssm_b_re': nrm((L, G, N, CH), (2 * CH) ** -0.5),
        'ssm_b_im': nrm((L, G, N, CH), (2 * CH) ** -0.5),
        'ssm_c_re': nrm((L, G, CH, N), (2 * N) ** -0.5),
        'ssm_c_im': nrm((L, G, CH, N), (2 * N) ** -0.5),
        'ssm_d': 1.0 + nrm((L, G, CH), 0.1),
        'w_glu': nrm((L, SSM_WIDTH, SSM_WIDTH), SSM_WIDTH ** -0.5),
        'b_glu': nrm((L, SSM_WIDTH), 0.02),
        'w_ssm_out': nrm((L, SSM_WIDTH, D), SSM_WIDTH ** -0.5),
        'w_out': nrm((L, D, D), D ** -0.5),
        'ffn2_norm': 1.0 + nrm((L, D), 0.02),
        'ffn2_w1': nrm((L, D, D_FF), D ** -0.5),
        'ffn2_w3': nrm((L, D, D_FF), D ** -0.5),
        'ffn2_w2': nrm((L, D_FF, D), D_FF ** -0.5),
    }


def reference(x_prompt, x_sample, cache_k, cache_v, state_ssm_re, state_ssm_im,
              ffn1_norm, ffn1_w1, ffn1_w3, ffn1_w2, mix_norm, w_in, q_norm, k_norm,
              attn_sinks, w_attn_out, ssm_a_re, ssm_a_im, ssm_log_dt, ssm_b_re, ssm_b_im,
              ssm_c_re, ssm_c_im, ssm_d, w_glu, b_glu, w_ssm_out, w_out,
              ffn2_norm, ffn2_w1, ffn2_w3, ffn2_w2):
    xp, xs = x_prompt, x_sample
    kp_l, vp_l, rp_l, ip_l = [], [], [], []
    ks_l, vs_l, rs_l, is_l = [], [], [], []
    for l in range(DEPTH):
        p = dict(ffn1_norm=ffn1_norm[l], ffn1_w1=ffn1_w1[l], ffn1_w3=ffn1_w3[l], ffn1_w2=ffn1_w2[l],
                 mix_norm=mix_norm[l], w_in=w_in[l], q_norm=q_norm[l], k_norm=k_norm[l],
                 attn_sinks=attn_sinks[l], w_attn_out=w_attn_out[l],
                 ssm_a_re=ssm_a_re[l], ssm_a_im=ssm_a_im[l], ssm_log_dt=ssm_log_dt[l],
                 ssm_b_re=ssm_b_re[l], ssm_b_im=ssm_b_im[l], ssm_c_re=ssm_c_re[l], ssm_c_im=ssm_c_im[l],
                 ssm_d=ssm_d[l], w_glu=w_glu[l], b_glu=b_glu[l], w_ssm_out=w_ssm_out[l], w_out=w_out[l],
                 ffn2_norm=ffn2_norm[l], ffn2_w1=ffn2_w1[l], ffn2_w3=ffn2_w3[l], ffn2_w2=ffn2_w2[l])
        xp, kp, vp, rp, ip = trunk_layer(xp, 0, None, None, None, None, p)
        xs, ks_, vs_, rs_, is_ = trunk_layer(xs, PAST_LEN, cache_k[l], cache_v[l],
                                             state_ssm_re[l], state_ssm_im[l], p)
        kp_l.append(kp); vp_l.append(vp); rp_l.append(rp); ip_l.append(ip)
        ks_l.append(ks_); vs_l.append(vs_); rs_l.append(rs_); is_l.append(is_)
    new_k_prompt, new_v_prompt = jnp.stack(kp_l), jnp.stack(vp_l)
    new_re_prompt, new_im_prompt = jnp.stack(rp_l), jnp.stack(ip_l)
    new_k_sample, new_v_sample = jnp.stack(ks_l), jnp.stack(vs_l)
    new_re_sample, new_im_sample = jnp.stack(rs_l), jnp.stack(is_l)
    return (xp, xs, new_k_prompt, new_v_prompt, new_re_prompt, new_im_prompt,
            new_k_sample, new_v_sample, new_re_sample, new_im_sample)
```

```cpp
#include <hip/hip_runtime.h>
#include <hip/hip_cooperative_groups.h>
#include <cstdio>
#include <cstdint>
namespace cg = cooperative_groups;

#define LAS __attribute__((address_space(3)))
typedef unsigned short bf16_t;
typedef short bf16x8 __attribute__((ext_vector_type(8)));
typedef float f32x4 __attribute__((ext_vector_type(4)));
typedef float f32x2 __attribute__((ext_vector_type(2)));
typedef float f32x16 __attribute__((ext_vector_type(16)));
typedef unsigned u32x4 __attribute__((ext_vector_type(4)));
typedef unsigned u32x2 __attribute__((ext_vector_type(2)));
typedef __bf16 bf16x2_t __attribute__((ext_vector_type(2)));

constexpr int D = 1024, FF = 2816, NIN = 3328;
constexpr int MP = 16384, MS = 512, M = MP + MS;
constexpr int SEQ = 8192, PAST = 16384;
constexpr float EPS = 1e-6f;
constexpr float LOG2E = 1.4426950408889634f;
constexpr size_t O_Y = 0, O_KP = 17301504, O_VP = 17334272, O_REP = 17367040, O_IMP = 17371136,
                 O_KS = 17375232, O_VS = 19472384, O_RES = 21569536, O_IMS = 21831680;
constexpr size_t KiB = 1024, MiB = 1024 * 1024;
constexpr size_t WS_RS0 = 0, WS_SS1 = 128 * KiB, WS_SS2 = 256 * KiB, WS_AB = 384 * KiB, WS_BBR = 512 * KiB, WS_BBI = 640 * KiB, WS_CMT = 768 * KiB;
constexpr size_t WS_E = 1 * MiB, WS_BBT = 3 * MiB;
constexpr size_t WS_W13A = 8 * MiB, WS_W2A = 19 * MiB, WS_WIN = WS_W2A + 5632 * KiB, WS_WGLU = 31 * MiB, WS_WAO = WS_WGLU + 512 * KiB, WS_WSO = WS_WAO + MiB,
                 WS_WOUT = WS_WSO + MiB, WS_W13B = WS_WOUT + 2 * MiB, WS_W2B = WS_W13B + 11 * MiB;
constexpr size_t WS_XB = 52 * MiB;
constexpr size_t WS_ACT = 85 * MiB;
constexpr size_t WS_Q = 85 * MiB, WS_K = WS_Q + (size_t)M * 512 * 2, WS_V = WS_K + (size_t)M * 128 * 2, WS_U = WS_V + (size_t)M * 128 * 2,
                 WS_GA = WS_U + (size_t)M * 512 * 2, WS_GS = WS_GA + (size_t)M * 1024 * 2;
constexpr size_t WS_MERGED = 85 * MiB;
constexpr size_t WS_ATTN = 193 * MiB, WS_Z = WS_ATTN + (size_t)M * 512 * 2, WS_SSMB = WS_Z + (size_t)M * 512 * 2, WS_END = WS_SSMB + (size_t)M * 512 * 2;
static_assert(WS_W2B + 5632 * KiB <= WS_XB && WS_XB + (size_t)M * 1024 * 2 <= WS_ACT && WS_GS + (size_t)M * 1024 * 2 <= WS_ATTN && WS_ACT + (size_t)M * FF * 2 <= WS_ATTN &&
              WS_END <= 256 * MiB && WS_WIN + (size_t)NIN * 1024 * 2 <= WS_WGLU && WS_E + 4 * MiB <= WS_W13A, "ws map");

constexpr int LDS_BYTES = 147456;

__device__ __forceinline__ unsigned cvt_pk(float lo, float hi) { f32x2 v = {lo, hi}; bf16x2_t b = __builtin_convertvector(v, bf16x2_t); return __builtin_bit_cast(unsigned, b); }
__device__ __forceinline__ float bf_lo(unsigned w) { return __uint_as_float(w << 16); }
__device__ __forceinline__ float bf_hi(unsigned w) { return __uint_as_float(w & 0xffff0000u); }
__device__ __forceinline__ float bf2f(bf16_t b) { return __uint_as_float((unsigned)b << 16); }
__device__ __forceinline__ void unpack8(u32x4 w, float* f) { f[0] = bf_lo(w.x); f[1] = bf_hi(w.x); f[2] = bf_lo(w.y); f[3] = bf_hi(w.y); f[4] = bf_lo(w.z); f[5] = bf_hi(w.z); f[6] = bf_lo(w.w); f[7] = bf_hi(w.w); }
__device__ __forceinline__ u32x4 pack8(const float* f) { u32x4 w; w.x = cvt_pk(f[0], f[1]); w.y = cvt_pk(f[2], f[3]); w.z = cvt_pk(f[4], f[5]); w.w = cvt_pk(f[6], f[7]); return w; }
__device__ __forceinline__ float fast_sigmoid(float x) { return __builtin_amdgcn_rcpf(1.f + __builtin_amdgcn_exp2f(-LOG2E * x)); }
__device__ __forceinline__ float wave_sum(float v) {
#pragma unroll
    for (int o = 1; o < 64; o <<= 1) v += __shfl_xor(v, o);
    return v;
}

namespace pg8 {
constexpr int BM = 256, BK = 64, HALF = 128, HTB = HALF * BK * 2, STAGE_BYTES = 8 * HTB, NXCD = 8, WGM = 8;
__host__ __device__ __forceinline__ int lds_byte(int r, int c) { const int st = (r >> 4) * 2 + (c >> 5), rr = r & 15, cc = c & 31, ob = rr * 64 + cc * 2; return st * 1024 + (ob ^ (((ob >> 9) & 1) << 5)); }
__host__ __device__ __forceinline__ void stage_rc(int b, int& R, int& C) { const int st = b / 1024, sb = b % 1024, swz = sb ^ (((sb >> 9) & 1) << 5); R = (st >> 1) * 16 + swz / 64; C = (st & 1) * 32 + (swz % 64) / 2; }
__host__ __device__ __forceinline__ int perm32(int rho) { const int n = rho >> 4, i = rho & 15; return 8 * (i >> 2) + 4 * n + (i & 3); }

struct Unit { int pm, pn; };
struct Gemm { const bf16_t* A; const bf16_t* Bt; int M, N, K, lda, ldb; };

struct StaticOrder {
    int nM, nN, nwg, G, c;
    __host__ __device__ void init(int M_, int N_, int G_, int c_) { nM = M_ / BM; nN = N_ / BM; nwg = nM * nN; G = G_; c = c_; }
    __host__ __device__ bool next(int i, Unit& u) const {
        const long L = (long)i * G + c; if (L >= nwg) return false;
        int wgid = (int)L; { const int q = nwg / NXCD, r = nwg % NXCD, xcd = wgid % NXCD, off = wgid / NXCD; wgid = (xcd < r ? xcd * (q + 1) : r * (q + 1) + (xcd - r) * q) + off; }
        const int nig = WGM * nN, gid = wgid / nig, fm = gid * WGM, gsz = (nM - fm) < WGM ? (nM - fm) : WGM;
        u.pm = fm + ((wgid % nig) % gsz); u.pn = (wgid % nig) / gsz; return true;
    }
};

template <class Epi, class Sched, bool ALIGN_EPI = true, bool SP2 = true>
__device__ __forceinline__ void gemm_phase(LAS unsigned char* lds, const Gemm g, const Sched& S, const Epi& E) {
    const int tid = threadIdx.x, wid = __builtin_amdgcn_readfirstlane(tid >> 6), lane = tid & 63, wr = wid >> 2, wc = wid & 3, fr = lane & 15, fq = lane >> 4;
    const int K = g.K, nt = K / BK;
    unsigned voffA[2], voffB[2];
#pragma unroll
    for (int i = 0; i < 2; ++i) { int R, C; stage_rc(tid * 16 + i * 8192, R, C); const int Rb = Epi::PERM ? ((R & ~31) + perm32(R & 31)) : R;
        voffA[i] = (unsigned)(R * g.lda + C) * 2u; voffB[i] = (unsigned)(Rb * g.ldb + C) * 2u; }
    const size_t kstep = (size_t)(BK * 2);
    const size_t hstepA = (size_t)HALF * g.lda * 2, hstepB = (size_t)HALF * g.ldb * 2;
    const size_t tstepA = 2 * hstepA, tstepB = 2 * hstepB;
    const unsigned ldsw = (unsigned)wid * 1024u;
    const int aoff = lds_byte(wr * 64 + fr, fq * 8), boff = lds_byte(wc * 32 + fr, fq * 8);
#define PG8_SA(b, h) (((b) * 2 + (h)) * HTB)
#define PG8_SB(b, h) ((4 + (b) * 2 + (h)) * HTB)
#define PG8_STAGE(bufoff, gbase, voff) do { _Pragma("unroll") for (int _i = 0; _i < 2; ++_i) \
        __builtin_amdgcn_global_load_lds((const unsigned*)((const char*)(gbase) + (voff)[_i]), (LAS unsigned*)(lds + (bufoff) + ldsw + _i * 8192), 16, 0, 0); } while (0)
#define PG8_LDA(dst, b, h) do { _Pragma("unroll") for (int m = 0; m < 4; ++m) _Pragma("unroll") for (int k = 0; k < 2; ++k) dst[m][k] = *(const LAS bf16x8*)(lds + PG8_SA(b, h) + aoff + m * 2048 + k * 1024); } while (0)
#define PG8_LDB(dst, b, h) do { _Pragma("unroll") for (int n = 0; n < 2; ++n) _Pragma("unroll") for (int k = 0; k < 2; ++k) dst[n][k] = *(const LAS bf16x8*)(lds + PG8_SB(b, h) + boff + n * 2048 + k * 1024); } while (0)
#define PG8_MMA(ai, bj, At, Bt) do { __builtin_amdgcn_s_setprio(1); _Pragma("unroll") for (int m = 0; m < 4; ++m) _Pragma("unroll") for (int n = 0; n < 2; ++n) _Pragma("unroll") for (int k = 0; k < 2; ++k) \
        acc[ai][bj][m][n] = __builtin_amdgcn_mfma_f32_16x16x32_bf16(Bt[n][k], At[m][k], acc[ai][bj][m][n], 0, 0, 0); __builtin_amdgcn_s_setprio(0); } while (0)
#define PG8_WAIT_V(n) asm volatile("s_waitcnt vmcnt(" #n ")" ::: "memory")
#define PG8_WAIT_L(n) asm volatile("s_waitcnt lgkmcnt(" #n ")" ::: "memory")
#define PG8_BAR __builtin_amdgcn_s_barrier()
#define PG8_SCHED __builtin_amdgcn_sched_barrier(0)
    Unit cur, nxt; int ui = 0;
    if (!S.next(0, cur)) return;
    f32x4 acc[2][2][4][2];
#pragma unroll
    for (int a = 0; a < 2; ++a)
#pragma unroll
        for (int b = 0; b < 2; ++b)
#pragma unroll
            for (int m = 0; m < 4; ++m)
#pragma unroll
                for (int n = 0; n < 2; ++n) acc[a][b][m][n] = (f32x4){0.f, 0.f, 0.f, 0.f};
    bf16x8 At[4][2], B0[2][2], B1[2][2];
    const char* cA = (const char*)g.A + (size_t)cur.pm * tstepA; const char* cB = (const char*)g.Bt + (size_t)cur.pn * tstepB;
    {
        PG8_STAGE(PG8_SB(0, 0), cB, voffB); PG8_STAGE(PG8_SB(0, 1), cB + hstepB, voffB); PG8_STAGE(PG8_SA(0, 0), cA, voffA); PG8_STAGE(PG8_SA(0, 1), cA + hstepA, voffA);
        if (wr == 1) PG8_BAR;
        PG8_WAIT_V(2); PG8_BAR;
        PG8_STAGE(PG8_SB(1, 0), cB + kstep, voffB); PG8_STAGE(PG8_SA(1, 0), cA + kstep, voffA); PG8_STAGE(PG8_SB(1, 1), cB + hstepB + kstep, voffB);
        PG8_WAIT_V(6); PG8_BAR;
    }
    for (;;) {
        const bool has_next = S.next(ui + 1, nxt);
        const char* nA = has_next ? (const char*)g.A + (size_t)nxt.pm * tstepA : cA; const char* nB = has_next ? (const char*)g.Bt + (size_t)nxt.pn * tstepB : cB;
        for (int t = 0; t < nt; t += 2) {
            const bool last = (t == nt - 2);
            const char* a1 = cA + (size_t)(t + 1) * kstep;
            const char* a2 = last ? nA : cA + (size_t)(t + 2) * kstep; const char* b2 = last ? nB : cB + (size_t)(t + 2) * kstep;
            const char* a3 = a2 + kstep; const char* b3 = b2 + kstep;
            PG8_LDB(B0, 0, 0); PG8_LDB(B1, 0, 1); PG8_SCHED; PG8_LDA(At, 0, 0); PG8_STAGE(PG8_SA(1, 1), a1 + hstepA, voffA);
            PG8_WAIT_V(8); PG8_WAIT_L(0); PG8_BAR; PG8_MMA(0, 0, At, B0); PG8_MMA(0, 1, At, B1); PG8_BAR; PG8_SCHED;
            PG8_LDA(At, 0, 1); PG8_STAGE(PG8_SB(0, 0), b2, voffB); PG8_STAGE(PG8_SB(0, 1), b2 + hstepB, voffB); PG8_STAGE(PG8_SA(0, 0), a2, voffA);
            PG8_WAIT_V(8); PG8_WAIT_L(0); PG8_BAR; PG8_MMA(1, 0, At, B0); PG8_MMA(1, 1, At, B1); PG8_BAR; PG8_SCHED;
            PG8_LDB(B0, 1, 0); PG8_LDB(B1, 1, 1); PG8_SCHED; PG8_LDA(At, 1, 0); PG8_STAGE(PG8_SA(0, 1), a2 + hstepA, voffA);
            PG8_WAIT_V(8); PG8_WAIT_L(0); PG8_BAR; PG8_MMA(0, 0, At, B0); PG8_MMA(0, 1, At, B1); PG8_BAR; PG8_SCHED;
            PG8_LDA(At, 1, 1); PG8_STAGE(PG8_SB(1, 0), b3, voffB); PG8_STAGE(PG8_SB(1, 1), b3 + hstepB, voffB); PG8_STAGE(PG8_SA(1, 0), a3, voffA);
            PG8_WAIT_V(8); PG8_WAIT_L(0); PG8_BAR; PG8_MMA(1, 0, At, B0); PG8_MMA(1, 1, At, B1); PG8_BAR; PG8_SCHED;
        }
        if constexpr (ALIGN_EPI) { if (wr == 0) PG8_BAR; }
        E(acc, cur, wr, wc, fr, fq);
        if (!has_next) break;
#pragma unroll
        for (int a = 0; a < 2; ++a)
#pragma unroll
            for (int b = 0; b < 2; ++b)
#pragma unroll
                for (int m = 0; m < 4; ++m)
#pragma unroll
                    for (int n = 0; n < 2; ++n) acc[a][b][m][n] = (f32x4){0.f, 0.f, 0.f, 0.f};
        cur = nxt; cA = nA; cB = nB; ++ui;
        if constexpr (ALIGN_EPI) { if (wr == 1) PG8_BAR; }
    }
    PG8_WAIT_V(0);
    if constexpr (!ALIGN_EPI) { if (wr == 0) PG8_BAR; }
    PG8_BAR;
#undef PG8_SA
#undef PG8_SB
#undef PG8_STAGE
#undef PG8_LDA
#undef PG8_LDB
#undef PG8_MMA
#undef PG8_WAIT_V
#undef PG8_WAIT_L
#undef PG8_BAR
#undef PG8_SCHED
}
}
using pg8::Unit;
typedef f32x4 AccT[2][2][4][2];

struct EpiSwiglu {
    static constexpr bool PERM = true;
    bf16_t* O; const float* rs; int rsmode;
    __device__ __forceinline__ void operator()(const AccT& acc, const Unit& u, int wr, int wc, int fr, int fq) const {
#pragma unroll
        for (int ai = 0; ai < 2; ++ai)
#pragma unroll
            for (int m = 0; m < 4; ++m) {
                const int row = u.pm * 256 + ai * 128 + wr * 64 + m * 16 + fr;
                float s = rs[row]; if (rsmode) s = rsqrtf(s * (1.f / 1024.f) + EPS);
                float o[8];
#pragma unroll
                for (int n = 0; n < 2; ++n)
#pragma unroll
                    for (int j = 0; j < 4; ++j) { const float a = acc[ai][0][m][n][j] * s, b = acc[ai][1][m][n][j] * s; o[n * 4 + j] = a * b * fast_sigmoid(a); }
                *(u32x4*)(O + (size_t)row * FF + u.pn * 128 + wc * 32 + fq * 8) = pack8(o);
            }
    }
};
struct EpiResid {
    static constexpr bool PERM = true;
    const float* base_p; const float* base_s; const bf16_t* base_b; float* out; bf16_t* xb; float* ss; float scale;
    __device__ __forceinline__ void operator()(const AccT& acc, const Unit& u, int wr, int wc, int fr, int fq) const {
#pragma unroll
        for (int ai = 0; ai < 2; ++ai)
#pragma unroll
            for (int m = 0; m < 4; ++m) {
                const int row = u.pm * 256 + ai * 128 + wr * 64 + m * 16 + fr;
                const float* bp = row < MP ? base_p + (size_t)row * D : base_s + (size_t)(row - MP) * D;
                float part = 0.f;
#pragma unroll
                for (int bj = 0; bj < 2; ++bj) {
                    const int c0 = u.pn * 256 + bj * 128 + wc * 32 + fq * 8;
                    f32x4 b0, b1;
                    if (base_b) { float t[8]; unpack8(xb ? *(const u32x4*)(base_b + (size_t)row * D + c0) : __builtin_nontemporal_load((const u32x4*)(base_b + (size_t)row * D + c0)), t); b0 = (f32x4){t[0], t[1], t[2], t[3]}; b1 = (f32x4){t[4], t[5], t[6], t[7]}; }
                    else { b0 = __builtin_nontemporal_load((const f32x4*)(bp + c0)); b1 = __builtin_nontemporal_load((const f32x4*)(bp + c0 + 4)); }
                    const f32x4 o0 = b0 + acc[ai][bj][m][0] * scale, o1 = b1 + acc[ai][bj][m][1] * scale;
                    if (out) { __builtin_nontemporal_store(o0, (f32x4*)(out + (size_t)row * D + c0)); __builtin_nontemporal_store(o1, (f32x4*)(out + (size_t)row * D + c0 + 4)); }
                    if (xb) { u32x4 w; w.x = cvt_pk(o0[0], o0[1]); w.y = cvt_pk(o0[2], o0[3]); w.z = cvt_pk(o1[0], o1[1]); w.w = cvt_pk(o1[2], o1[3]); *(u32x4*)(xb + (size_t)row * D + c0) = w; }
                    part += (o0[0] * o0[0] + o0[1] * o0[1]) + (o0[2] * o0[2] + o0[3] * o0[3]) + (o1[0] * o1[0] + o1[1] * o1[1]) + (o1[2] * o1[2] + o1[3] * o1[3]);
                }
                if (ss) { part += __shfl_xor(part, 16); part += __shfl_xor(part, 32); if (fq == 0) unsafeAtomicAdd(ss + row, part); }
            }
    }
    __device__ __forceinline__ void tail(f32x4 v, int row, int col, int lane) const {
        f32x4 bv;
        if (base_b) { const u32x2 w = *(const u32x2*)(base_b + (size_t)row * D + col); bv = (f32x4){bf_lo(w.x), bf_hi(w.x), bf_lo(w.y), bf_hi(w.y)}; }
        else bv = *(const f32x4*)(base_s + (size_t)(row - MP) * D + col);
        const f32x4 o = bv + v * scale;
        if (out) *(f32x4*)(out + (size_t)row * D + col) = o;
        if (xb) { u32x2 w; w.x = cvt_pk(o[0], o[1]); w.y = cvt_pk(o[2], o[3]); *(u32x2*)(xb + (size_t)row * D + col) = w; }
        if (ss) { float part = (o[0] * o[0] + o[1] * o[1]) + (o[2] * o[2] + o[3] * o[3]);
            part += __shfl_xor(part, 1); part += __shfl_xor(part, 2); part += __shfl_xor(part, 4); part += __shfl_xor(part, 8);
            if ((lane & 15) == 0) unsafeAtomicAdd(ss + row, part); }
    }
};
struct EpiProj {
    static constexpr bool PERM = true;
    const float* ss1; unsigned char* ws; const float* gq; const float* gk; float* out;
    __device__ __forceinline__ void operator()(const AccT& acc, const Unit& u, int wr, int wc, int fr, int fq) const {
        const int pn = u.pn;
        if (pn <= 2) {
            const bool is_v = (pn == 2 && wc >= 2), is_q = pn < 2;
            const float* g = is_q ? gq : gk;
            float g1[8], g2[8], invf[8];
#pragma unroll
            for (int i = 0; i < 8; ++i) { g1[i] = g[fq * 8 + i]; g2[i] = g[32 + fq * 8 + i]; invf[i] = __builtin_amdgcn_exp2f(-(float)(fq * 8 + i) * 0.41524101186092029f) * 0.15915494309189535f; }
            const float osc = is_q ? 0.125f * LOG2E : 1.f;
#pragma unroll
            for (int ai = 0; ai < 2; ++ai)
#pragma unroll
                for (int m = 0; m < 4; ++m) {
                    const int row = u.pm * 256 + ai * 128 + wr * 64 + m * 16 + fr;
                    const float s = rsqrtf(ss1[row] * (1.f / 1024.f) + EPS);
                    float x1[8], x2[8];
#pragma unroll
                    for (int n = 0; n < 2; ++n)
#pragma unroll
                        for (int j = 0; j < 4; ++j) { x1[n * 4 + j] = acc[ai][0][m][n][j] * s; x2[n * 4 + j] = acc[ai][1][m][n][j] * s; }
                    if (!is_v) {
                        float q = 0.f;
#pragma unroll
                        for (int i = 0; i < 8; ++i) q += x1[i] * x1[i] + x2[i] * x2[i];
                        q += __shfl_xor(q, 16); q += __shfl_xor(q, 32);
                        const float inv = rsqrtf(q * (1.f / 64.f) + EPS);
                        const float pos = row < MP ? (float)(row & (SEQ - 1)) : (float)(PAST + ((row - MP) & 3));
#pragma unroll
                        for (int i = 0; i < 8; ++i) {
                            const float a = x1[i] * inv * g1[i], b = x2[i] * inv * g2[i];
                            float rev = pos * invf[i]; rev = rev - floorf(rev);
                            const float sn = __builtin_amdgcn_sinf(rev), cs = __builtin_amdgcn_cosf(rev);
                            x1[i] = (a * cs - b * sn) * osc; x2[i] = (b * cs + a * sn) * osc;
                        }
                    }
                    if (is_q) {
                        bf16_t* dst = (bf16_t*)(ws + WS_Q) + (size_t)row * 512 + (4 * pn + wc) * 64 + fq * 8;
                        *(u32x4*)dst = pack8(x1); *(u32x4*)(dst + 32) = pack8(x2);
                    } else {
                        const int kvh = wc & 1;
                        bf16_t* dst = (bf16_t*)(ws + (is_v ? WS_V : WS_K)) + (size_t)row * 128 + kvh * 64 + fq * 8;
                        *(u32x4*)dst = pack8(x1); *(u32x4*)(dst + 32) = pack8(x2);
                        float* od = nullptr;
                        if (row >= MP) { const int sr = row - MP, b = sr >> 2, t = sr & 3; od = out + (is_v ? O_VS : O_KS) + ((size_t)(b * 128 + 124 + t) * 2 + kvh) * 64 + fq * 8; }
                        else if ((row & (SEQ - 1)) >= SEQ - 128) { const int b = row >> 13, w = (row & (SEQ - 1)) - (SEQ - 128); od = out + (is_v ? O_VP : O_KP) + ((size_t)(b * 128 + w) * 2 + kvh) * 64 + fq * 8; }
                        if (od) {
                            *(f32x4*)od = (f32x4){x1[0], x1[1], x1[2], x1[3]}; *(f32x4*)(od + 4) = (f32x4){x1[4], x1[5], x1[6], x1[7]};
                            *(f32x4*)(od + 32) = (f32x4){x2[0], x2[1], x2[2], x2[3]}; *(f32x4*)(od + 36) = (f32x4){x2[4], x2[5], x2[6], x2[7]};
                        }
                    }
                }
        } else {
            const bool is_u = pn <= 4;
            size_t dofs; int ld, ct;
            if (is_u) { dofs = WS_U; ld = 512; ct = pn - 3; } else if (pn <= 8) { dofs = WS_GA; ld = 1024; ct = pn - 5; } else { dofs = WS_GS; ld = 1024; ct = pn - 9; }
            bf16_t* dstb = (bf16_t*)(ws + dofs);
#pragma unroll
            for (int ai = 0; ai < 2; ++ai)
#pragma unroll
                for (int m = 0; m < 4; ++m) {
                    const int row = u.pm * 256 + ai * 128 + wr * 64 + m * 16 + fr;
                    const float s = rsqrtf(ss1[row] * (1.f / 1024.f) + EPS);
#pragma unroll
                    for (int bj = 0; bj < 2; ++bj) {
                        float o[8];
#pragma unroll
                        for (int n = 0; n < 2; ++n)
#pragma unroll
                            for (int j = 0; j < 4; ++j) { const float v = acc[ai][bj][m][n][j] * s; o[n * 4 + j] = is_u ? v : fast_sigmoid(v); }
                        *(u32x4*)(dstb + (size_t)row * ld + ct * 256 + bj * 128 + wc * 32 + fq * 8) = pack8(o);
                    }
                }
        }
    }
};
struct EpiGlu {
    static constexpr bool PERM = true;
    const bf16_t* Z; const float* bias; bf16_t* O;
    __device__ __forceinline__ void operator()(const AccT& acc, const Unit& u, int wr, int wc, int fr, int fq) const {
#pragma unroll
        for (int ai = 0; ai < 2; ++ai)
#pragma unroll
            for (int m = 0; m < 4; ++m) {
                const int row = u.pm * 256 + ai * 128 + wr * 64 + m * 16 + fr;
#pragma unroll
                for (int bj = 0; bj < 2; ++bj) {
                    const int c0 = u.pn * 256 + bj * 128 + wc * 32 + fq * 8;
                    float z[8], o[8]; unpack8(*(const u32x4*)(Z + (size_t)row * 512 + c0), z);
                    const f32x4 b0 = *(const f32x4*)(bias + c0), b1 = *(const f32x4*)(bias + c0 + 4);
#pragma unroll
                    for (int j = 0; j < 4; ++j) { o[j] = z[j] * fast_sigmoid(acc[ai][bj][m][0][j] + b0[j]); o[4 + j] = z[4 + j] * fast_sigmoid(acc[ai][bj][m][1][j] + b1[j]); }
                    *(u32x4*)(O + (size_t)row * 512 + c0) = pack8(o);
                }
            }
    }
};
template <bool ADD> struct EpiGate {
    static constexpr bool PERM = true;
    const bf16_t* G; bf16_t* O;
    __device__ __forceinline__ void operator()(const AccT& acc, const Unit& u, int wr, int wc, int fr, int fq) const {
#pragma unroll
        for (int ai = 0; ai < 2; ++ai)
#pragma unroll
            for (int m = 0; m < 4; ++m) {
                const int row = u.pm * 256 + ai * 128 + wr * 64 + m * 16 + fr;
#pragma unroll
                for (int bj = 0; bj < 2; ++bj) {
                    const size_t off = (size_t)row * 1024 + u.pn * 256 + bj * 128 + wc * 32 + fq * 8;
                    float gt[8], o[8]; unpack8(__builtin_nontemporal_load((const u32x4*)(G + off)), gt);
                    if (ADD) unpack8(*(const u32x4*)(O + off), o); else {
#pragma unroll
                        for (int j = 0; j < 8; ++j) o[j] = 0.f; }
#pragma unroll
                    for (int j = 0; j < 4; ++j) { o[j] += gt[j] * acc[ai][bj][m][0][j]; o[4 + j] += gt[4 + j] * acc[ai][bj][m][1][j]; }
                    *(u32x4*)(O + off) = pack8(o);
                }
            }
    }
    __device__ __forceinline__ void tail(f32x4 v, int row, int col, int lane) const {
        const size_t off = (size_t)row * 1024 + col;
        const u32x2 gw = __builtin_nontemporal_load((const u32x2*)(G + off));
        f32x4 o = (f32x4){0.f, 0.f, 0.f, 0.f};
        if (ADD) { const u32x2 pw = *(const u32x2*)(O + off); o = (f32x4){bf_lo(pw.x), bf_hi(pw.x), bf_lo(pw.y), bf_hi(pw.y)}; }
        o[0] += bf_lo(gw.x) * v[0]; o[1] += bf_hi(gw.x) * v[1]; o[2] += bf_lo(gw.y) * v[2]; o[3] += bf_hi(gw.y) * v[3];
        u32x2 w; w.x = cvt_pk(o[0], o[1]); w.y = cvt_pk(o[2], o[3]); *(u32x2*)(O + off) = w;
    }
};

template <class TEpi>
__device__ __forceinline__ void tail_gemm(LAS unsigned char* lds, const bf16_t* A, int lda, const bf16_t* Bt, int ldb, int K, int tile, const TEpi& E, int tid, int lane, int wave) {
    const int tm = tile >> 4, tn = tile & 15, c = lane & 15, q4 = lane >> 4;
    const int kw = K >> 3, nsteps = kw >> 5;
    f32x4 acc[2][4];
#pragma unroll
    for (int mt = 0; mt < 2; ++mt)
#pragma unroll
        for (int nt = 0; nt < 4; ++nt) acc[mt][nt] = (f32x4){0.f, 0.f, 0.f, 0.f};
    const bf16_t* ap = A + (size_t)(tm * 32 + c) * lda + wave * kw + 8 * q4;
    const bf16_t* bp = Bt + (size_t)(tn * 64 + c) * ldb + wave * kw + 8 * q4;
#pragma unroll 1
    for (int s0 = 0; s0 < nsteps; s0 += 6) {
        const int cnt = nsteps - s0;
        bf16x8 af[6][2], bf[6][4];
#pragma unroll
        for (int j = 0; j < 6; ++j) if (j < cnt) {
#pragma unroll
            for (int mt = 0; mt < 2; ++mt) af[j][mt] = *(const bf16x8*)(ap + (size_t)mt * 16 * lda + (s0 + j) * 32);
#pragma unroll
            for (int nt = 0; nt < 4; ++nt) bf[j][nt] = *(const bf16x8*)(bp + (size_t)nt * 16 * ldb + (s0 + j) * 32);
        }
#pragma unroll
        for (int j = 0; j < 6; ++j) if (j < cnt) {
#pragma unroll
            for (int mt = 0; mt < 2; ++mt)
#pragma unroll
                for (int nt = 0; nt < 4; ++nt) acc[mt][nt] = __builtin_amdgcn_mfma_f32_16x16x32_bf16(af[j][mt], bf[j][nt], acc[mt][nt], 0, 0, 0);
        }
    }
    asm volatile("s_nop 15" : "+v"(acc[0][0]), "+v"(acc[0][1]), "+v"(acc[0][2]), "+v"(acc[0][3]), "+v"(acc[1][0]), "+v"(acc[1][1]), "+v"(acc[1][2]), "+v"(acc[1][3]));
    LAS float* part = (LAS float*)lds + wave * 2048;
#pragma unroll
    for (int mt = 0; mt < 2; ++mt)
#pragma unroll
        for (int nt = 0; nt < 4; ++nt)
#pragma unroll
            for (int i = 0; i < 4; ++i) part[(16 * mt + 4 * q4 + i) * 64 + 16 * nt + c] = acc[mt][nt][i];
    __syncthreads();
    const int row = tid >> 4, cg4 = (tid & 15) * 4;
    f32x4 sum = (f32x4){0.f, 0.f, 0.f, 0.f};
#pragma unroll
    for (int w = 0; w < 8; ++w) sum += *(const LAS f32x4*)((LAS float*)lds + w * 2048 + row * 64 + cg4);
    E.tail(sum, MP + tm * 32 + row, tn * 64 + cg4, lane);
    __syncthreads();
}

struct Args { const float* in[32]; float* out; unsigned char* ws; int ph_lo, ph_hi; };
enum { I_XP = 0, I_XS, I_CK, I_CV, I_SRE, I_SIM, I_F1N, I_F1W1, I_F1W3, I_F1W2, I_MIXN, I_WIN, I_QN, I_KN, I_SINK, I_WAO, I_ARE, I_AIM, I_LDT, I_BRE, I_BIM,
       I_CRE, I_CIM, I_DSK, I_WGLU, I_BGLU, I_WSO, I_WOUT, I_F2N, I_F2W1, I_F2W3, I_F2W2 };

__device__ __forceinline__ void transpose_item(const float* W, int ldw, int cola, int colb, const float* gain, bf16_t* WT, int ldt, int drow0, int k0, LAS float* scr, int lane) {
    const int n4 = (lane & 15) * 4, scol = (n4 < 32 ? cola + n4 : colb + n4 - 32);
    f32x4 v[16];
#pragma unroll
    for (int i = 0; i < 16; ++i) { const int kk = 4 * i + (lane >> 4); v[i] = __builtin_nontemporal_load((const f32x4*)(W + (size_t)(k0 + kk) * ldw + scol)); }
#pragma unroll
    for (int i = 0; i < 16; ++i) { const int kk = 4 * i + (lane >> 4); const float gk = gain ? gain[k0 + kk] : 1.f; LAS float* d = scr + kk * 65 + n4;
        d[0] = v[i][0] * gk; d[1] = v[i][1] * gk; d[2] = v[i][2] * gk; d[3] = v[i][3] * gk; }
    asm volatile("s_waitcnt lgkmcnt(0)" ::: "memory");
    const int c = lane & 7;
#pragma unroll
    for (int j = 0; j < 8; ++j) { const int n = (lane >> 3) + 8 * j; const LAS float* sp = scr + (8 * c) * 65 + n;
        u32x4 o; o.x = cvt_pk(sp[0 * 65], sp[1 * 65]); o.y = cvt_pk(sp[2 * 65], sp[3 * 65]); o.z = cvt_pk(sp[4 * 65], sp[5 * 65]); o.w = cvt_pk(sp[6 * 65], sp[7 * 65]);
        *(u32x4*)(WT + (size_t)(drow0 + n) * ldt + k0 + 8 * c) = o; }
    asm volatile("s_waitcnt lgkmcnt(0)" ::: "memory");
}

__device__ __forceinline__ void prologue(const Args& a, LAS unsigned char* lds, int tid, int lane, int wave, int G) {
    unsigned char* ws = a.ws;
    LAS float* scr = (LAS float*)(lds + wave * 16640);
    const int gw = blockIdx.x * 8 + wave, NGW = G * 8;
    constexpr int I13 = 88 * 16, I2 = 16 * 44, IIN = 52 * 16, IGLU = 8 * 8, IAO = 16 * 8, IOUT = 16 * 16;
    constexpr int NIT = 2 * I13 + 2 * I2 + IIN + IGLU + 2 * IAO + IOUT;
    for (int it = gw; it < NIT; it += NGW) {
        int r = it;
        if (r < 2 * I13) {
            const int which = r / I13; r -= which * I13; const int nb = r / 16, kb = r % 16, p = nb >> 2, h = (nb >> 1) & 1, j0 = (nb & 1) * 64;
            const float* W = which ? (h ? a.in[I_F2W3] : a.in[I_F2W1]) : (h ? a.in[I_F1W3] : a.in[I_F1W1]);
            transpose_item(W, FF, 128 * p + j0, 128 * p + j0 + 32, which ? a.in[I_F2N] : a.in[I_F1N], (bf16_t*)(ws + (which ? WS_W13B : WS_W13A)), 1024, nb * 64, kb * 64, scr, lane); continue; }
        r -= 2 * I13;
        if (r < 2 * I2) { const int which = r / I2; r -= which * I2; const int nb = r / 44, kb = r % 44;
            transpose_item(which ? a.in[I_F2W2] : a.in[I_F1W2], D, nb * 64, nb * 64 + 32, nullptr, (bf16_t*)(ws + (which ? WS_W2B : WS_W2A)), FF, nb * 64, kb * 64, scr, lane); continue; }
        r -= 2 * I2;
        if (r < IIN) { const int nb = r / 16, kb = r % 16, pn = nb >> 2, cb = (nb & 3) * 2;
            const int cola = pn <= 2 ? 256 * pn + 64 * (cb & 3) + 32 * (cb >> 2) : nb * 64, colb = pn <= 2 ? 256 * pn + 64 * ((cb + 1) & 3) + 32 * ((cb + 1) >> 2) : nb * 64 + 32;
            transpose_item(a.in[I_WIN], NIN, cola, colb, a.in[I_MIXN], (bf16_t*)(ws + WS_WIN), 1024, nb * 64, kb * 64, scr, lane); continue; }
        r -= IIN;
        if (r < IGLU) { const int nb = r / 8, kb = r % 8; transpose_item(a.in[I_WGLU], 512, nb * 64, nb * 64 + 32, nullptr, (bf16_t*)(ws + WS_WGLU), 512, nb * 64, kb * 64, scr, lane); continue; }
        r -= IGLU;
        if (r < 2 * IAO) { const int which = r / IAO; r -= which * IAO; const int nb = r / 8, kb = r % 8;
            transpose_item(which ? a.in[I_WSO] : a.in[I_WAO], D, nb * 64, nb * 64 + 32, nullptr, (bf16_t*)(ws + (which ? WS_WSO : WS_WAO)), 512, nb * 64, kb * 64, scr, lane); continue; }
        r -= 2 * IAO;
        { const int nb = r / 16, kb = r % 16; transpose_item(a.in[I_WOUT], D, nb * 64, nb * 64 + 32, nullptr, (bf16_t*)(ws + WS_WOUT), 1024, nb * 64, kb * 64, scr, lane); }
    }
    float* rs0 = (float*)(ws + WS_RS0); bf16_t* XB = (bf16_t*)(ws + WS_XB);
    for (int grp = blockIdx.x; grp < M / 32; grp += G)
#pragma unroll 1
      for (int j4 = 0; j4 < 4; ++j4) {
        const int m = grp * 32 + wave * 4 + j4;
        const float* xr = m < MP ? a.in[I_XP] + (size_t)m * D : a.in[I_XS] + (size_t)(m - MP) * D;
        f32x4 v[4]; float s = 0.f;
#pragma unroll
        for (int j = 0; j < 4; ++j) { v[j] = __builtin_nontemporal_load((const f32x4*)xr + lane + 64 * j); s += (v[j][0] * v[j][0] + v[j][1] * v[j][1]) + (v[j][2] * v[j][2] + v[j][3] * v[j][3]); }
        s = wave_sum(s);
        if (lane == 0) rs0[m] = rsqrtf(s * (1.f / 1024.f) + EPS);
#pragma unroll
        for (int j = 0; j < 4; ++j) { u32x2 w; w.x = cvt_pk(v[j][0], v[j][1]); w.y = cvt_pk(v[j][2], v[j][3]); ((u32x2*)(XB + (size_t)m * D))[lane + 64 * j] = w; }
      }
    const int gt = blockIdx.x * 512 + tid, NGT = G * 512;
    { float* ss1 = (float*)(ws + WS_SS1); float* ss2 = (float*)(ws + WS_SS2); for (int i = gt; i < M; i += NGT) { ss1[i] = 0.f; ss2[i] = 0.f; } }
    if (gt < 2048) {
        const int g = gt >> 6, n = gt & 63;
        const float dt = expf(a.in[I_LDT][g]), are = a.in[I_ARE][gt], aim = a.in[I_AIM][gt];
        const float mag = expf(dt * are), abr = mag * cosf(dt * aim), abi = mag * sinf(dt * aim);
        const float den = are * are + aim * aim, nr = abr - 1.f, ni = abi;
        const float fre = (nr * are + ni * aim) / den, fim = (ni * are - nr * aim) / den;
        float* AB = (float*)(ws + WS_AB); bf16_t* BBT = (bf16_t*)(ws + WS_BBT); bf16_t* CMT = (bf16_t*)(ws + WS_CMT);
        float pr = abr, pi = abi;
#pragma unroll
        for (int i = 0; i < 8; ++i) { const float t = pr * pr - pi * pi; pi = 2.f * pr * pi; pr = t; }
        AB[gt] = abr; AB[2048 + gt] = abi; AB[4096 + gt] = pr; AB[6144 + gt] = pi;
        for (int c = 0; c < 16; ++c) {
            const float br = a.in[I_BRE][gt * 16 + c], bi = a.in[I_BIM][gt * 16 + c];
            { const float vr = fre * br - fim * bi, vi = fre * bi + fim * br;
              const unsigned hr = cvt_pk(vr, 0.f) & 0xffffu, hi_ = cvt_pk(vi, 0.f) & 0xffffu;
              const unsigned lr = cvt_pk(vr - __uint_as_float(hr << 16), 0.f) & 0xffffu, li = cvt_pk(vi - __uint_as_float(hi_ << 16), 0.f) & 0xffffu;
              bf16_t* t0 = BBT + (size_t)(g * 128 + 2 * n) * 32 + c; t0[0] = (bf16_t)hr; t0[16] = (bf16_t)lr; t0[32] = (bf16_t)hi_; t0[48] = (bf16_t)li; }
            const float cr = a.in[I_CRE][(g * 16 + c) * 64 + n], ci = a.in[I_CIM][(g * 16 + c) * 64 + n];
            *(unsigned*)(CMT + (size_t)(g * 16 + c) * 128 + 2 * n) = cvt_pk(cr, -ci);
        }
    }
}

constexpr int KP = 144, VP = 520;
constexpr int AT_K = 0, AT_V = 256 * KP;
__device__ __forceinline__ void attn_wave_task(const LAS unsigned char* lds, int kbase, const bf16_t* qptr, int rl, int kmin, float sink, bf16_t* optr, bool store, int lane) {
    const int r = lane & 31, h = lane >> 5;
    bf16x8 qf[4];
#pragma unroll
    for (int s = 0; s < 4; ++s) qf[s] = *(const bf16x8*)(qptr + 16 * s + 8 * h);
    f32x16 S[5];
#pragma unroll
    for (int kt = 0; kt < 5; ++kt) {
#pragma unroll
        for (int i = 0; i < 16; ++i) S[kt][i] = 0.f;
#pragma unroll
        for (int s = 0; s < 4; ++s) {
            const bf16x8 kf = *(const LAS bf16x8*)(lds + AT_K + (kbase + 32 * kt + r) * KP + 32 * s + 16 * h);
            S[kt] = __builtin_amdgcn_mfma_f32_32x32x16_bf16(kf, qf[s], S[kt], 0, 0, 0);
        }
    }
    float mx = sink;
#pragma unroll
    for (int kt = 0; kt < 5; ++kt)
#pragma unroll
        for (int i = 0; i < 16; ++i) {
            const int kk = 32 * kt + (i & 3) + 8 * (i >> 2) + 4 * h;
            const bool ok = (kk > rl) && (kk <= 128 + rl) && (kk >= kmin);
            const float v = ok ? S[kt][i] : -1e30f; S[kt][i] = v; mx = fmaxf(mx, v);
        }
    mx = fmaxf(mx, __shfl_xor(mx, 32));
    float sum = 0.f;
#pragma unroll
    for (int kt = 0; kt < 5; ++kt)
#pragma unroll
        for (int i = 0; i < 16; ++i) { const float p = __builtin_amdgcn_exp2f(S[kt][i] - mx); S[kt][i] = p; sum += p; }
    sum += __shfl_xor(sum, 32);
    const float rden = 1.f / (sum + __builtin_amdgcn_exp2f(sink - mx));
    f32x16 O[2];
#pragma unroll
    for (int dt = 0; dt < 2; ++dt)
#pragma unroll
        for (int i = 0; i < 16; ++i) O[dt][i] = 0.f;
#pragma unroll
    for (int kt = 0; kt < 5; ++kt)
#pragma unroll
        for (int s2 = 0; s2 < 2; ++s2) {
            u32x4 pw; pw.x = cvt_pk(S[kt][8 * s2 + 0], S[kt][8 * s2 + 1]); pw.y = cvt_pk(S[kt][8 * s2 + 2], S[kt][8 * s2 + 3]);
            pw.z = cvt_pk(S[kt][8 * s2 + 4], S[kt][8 * s2 + 5]); pw.w = cvt_pk(S[kt][8 * s2 + 6], S[kt][8 * s2 + 7]);
            const bf16x8 pf = __builtin_bit_cast(bf16x8, pw);
#pragma unroll
            for (int dt = 0; dt < 2; ++dt) {
                const LAS unsigned char* vp = lds + AT_V + (32 * dt + r) * VP + (kbase + 32 * kt + 16 * s2 + 4 * h) * 2;
                const u32x2 v0 = *(const LAS u32x2*)vp, v1 = *(const LAS u32x2*)(vp + 16);
                u32x4 vw; vw.x = v0.x; vw.y = v0.y; vw.z = v1.x; vw.w = v1.y;
                O[dt] = __builtin_amdgcn_mfma_f32_32x32x16_bf16(__builtin_bit_cast(bf16x8, vw), pf, O[dt], 0, 0, 0);
            }
        }
    if (store) {
#pragma unroll
        for (int dt = 0; dt < 2; ++dt)
#pragma unroll
            for (int g4 = 0; g4 < 4; ++g4) {
                u32x2 w; w.x = cvt_pk(O[dt][4 * g4 + 0] * rden, O[dt][4 * g4 + 1] * rden); w.y = cvt_pk(O[dt][4 * g4 + 2] * rden, O[dt][4 * g4 + 3] * rden);
                *(u32x2*)(optr + 32 * dt + 8 * g4 + 4 * h) = w;
            }
    }
}

__device__ __forceinline__ void attn_unit(const Args& a, LAS unsigned char* lds, int unit, int tid, int lane, int wave) {
    unsigned char* ws = a.ws;
    const bf16_t* Qb = (const bf16_t*)(ws + WS_Q); const bf16_t* Kb = (const bf16_t*)(ws + WS_K); const bf16_t* Vb = (const bf16_t*)(ws + WS_V); bf16_t* AO = (bf16_t*)(ws + WS_ATTN);
    const float* sinks = a.in[I_SINK];
    if (unit < 256) {
        const int b = unit >> 7, kvh = (unit >> 6) & 1, qb = unit & 63;
#pragma unroll
        for (int i = 0; i < 4; ++i) {
            const int q = tid + 512 * i, c = q >> 3, dch = q & 7, t = (qb - 1) * 128 + c;
            u32x4 kv = (u32x4){0u, 0u, 0u, 0u}, vv = kv;
            if (t >= 0) { const size_t off = (size_t)(b * SEQ + t) * 128 + kvh * 64 + dch * 8; kv = *(const u32x4*)(Kb + off); vv = *(const u32x4*)(Vb + off); }
            *(LAS u32x4*)(lds + AT_K + c * KP + dch * 16) = kv;
            LAS bf16_t* vt = (LAS bf16_t*)(lds + AT_V + (dch * 8) * VP + c * 2);
            vt[0 * (VP / 2)] = (bf16_t)(vv.x & 0xffff); vt[1 * (VP / 2)] = (bf16_t)(vv.x >> 16); vt[2 * (VP / 2)] = (bf16_t)(vv.y & 0xffff); vt[3 * (VP / 2)] = (bf16_t)(vv.y >> 16);
            vt[4 * (VP / 2)] = (bf16_t)(vv.z & 0xffff); vt[5 * (VP / 2)] = (bf16_t)(vv.z >> 16); vt[6 * (VP / 2)] = (bf16_t)(vv.w & 0xffff); vt[7 * (VP / 2)] = (bf16_t)(vv.w >> 16);
        }
        __syncthreads();
#pragma unroll 1
        for (int task = wave; task < 16; task += 8) {
            const int hq = task >> 2, r0 = 32 * (task & 3), r = lane & 31;
            const size_t row = (size_t)b * SEQ + qb * 128 + r0 + r; const int head = kvh * 4 + hq;
            attn_wave_task(lds, r0, Qb + row * 512 + head * 64, r, qb == 0 ? 128 - r0 : 0, sinks[head] * LOG2E, AO + row * 512 + head * 64, true, lane);
        }
        __syncthreads();
    } else {
        const int su = unit - 256, b = su >> 1, kvh = su & 1;
        for (int q = tid; q < 160 * 8; q += 512) {
            const int c = q >> 3, dch = q & 7;
            u32x4 kv = (u32x4){0u, 0u, 0u, 0u}, vv = kv;
            if (c < 128) {
                const size_t off = ((size_t)(b * 128 + c) * 2 + kvh) * 64 + dch * 8;
                const f32x4 k0 = *(const f32x4*)(a.in[I_CK] + off), k1 = *(const f32x4*)(a.in[I_CK] + off + 4), v0 = *(const f32x4*)(a.in[I_CV] + off), v1 = *(const f32x4*)(a.in[I_CV] + off + 4);
                kv.x = cvt_pk(k0[0], k0[1]); kv.y = cvt_pk(k0[2], k0[3]); kv.z = cvt_pk(k1[0], k1[1]); kv.w = cvt_pk(k1[2], k1[3]);
                vv.x = cvt_pk(v0[0], v0[1]); vv.y = cvt_pk(v0[2], v0[3]); vv.z = cvt_pk(v1[0], v1[1]); vv.w = cvt_pk(v1[2], v1[3]);
            } else if (c < 132) { const size_t off = (size_t)(MP + 4 * b + (c - 128)) * 128 + kvh * 64 + dch * 8; kv = *(const u32x4*)(Kb + off); vv = *(const u32x4*)(Vb + off); }
            *(LAS u32x4*)(lds + AT_K + c * KP + dch * 16) = kv;
            LAS bf16_t* vt = (LAS bf16_t*)(lds + AT_V + (dch * 8) * VP + c * 2);
            vt[0 * (VP / 2)] = (bf16_t)(vv.x & 0xffff); vt[1 * (VP / 2)] = (bf16_t)(vv.x >> 16); vt[2 * (VP / 2)] = (bf16_t)(vv.y & 0xffff); vt[3 * (VP / 2)] = (bf16_t)(vv.y >> 16);
            vt[4 * (VP / 2)] = (bf16_t)(vv.z & 0xffff); vt[5 * (VP / 2)] = (bf16_t)(vv.z >> 16); vt[6 * (VP / 2)] = (bf16_t)(vv.w & 0xffff); vt[7 * (VP / 2)] = (bf16_t)(vv.w >> 16);
        }
        __syncthreads();
        if (wave == 0) {
            const int i = lane & 15, hq = i >> 2, t = i & 3, head = kvh * 4 + hq;
            const size_t row = (size_t)MP + 4 * b + t;
            attn_wave_task(lds, 0, Qb + row * 512 + head * 64, t, 0, sinks[head] * LOG2E, AO + row * 512 + head * 64, (lane & 31) < 16, lane);
        }
        __syncthreads();
    }
}

constexpr int BUP = 528, XP = 272, SSM_WLDS = 16 * BUP + 16 * XP;
template <int PASS>
__device__ __forceinline__ void ssm_item(const Args& a, LAS unsigned char* wl, int b, int g, int seg, bool sample, int lane) {
    unsigned char* ws = a.ws;
    const bf16_t* U = (const bf16_t*)(ws + WS_U); const float* AB = (const float*)(ws + WS_AB); const bf16_t* BBT = (const bf16_t*)(ws + WS_BBT);
    f32x2* E = (f32x2*)(ws + WS_E);
    LAS unsigned char* bu = wl; LAS unsigned char* xl = wl + 16 * BUP;
    int row0, nblk, tcount;
    if (sample) { row0 = MP + 4 * b; nblk = 1; tcount = 4; }
    else { row0 = b * SEQ + seg * 256; nblk = 16; tcount = 16; }
    const int n = lane, gn = g * 64 + n, c = lane & 15, q4 = lane >> 4;
    const bf16x8 zero8 = (bf16x8){0, 0, 0, 0, 0, 0, 0, 0};
    bf16x8 bb[8];
#pragma unroll
    for (int vt = 0; vt < 8; ++vt) bb[vt] = *(const bf16x8*)(BBT + (size_t)((g * 128 + 16 * vt + c) * 32 + 8 * q4));
    const float abr = AB[gn], abi = AB[2048 + gn];
    float xr = 0.f, xi = 0.f;
    if (PASS == 2) {
        if (sample) { xr = a.in[I_SRE][(size_t)(b * 32 + g) * 64 + n]; xi = a.in[I_SIM][(size_t)(b * 32 + g) * 64 + n]; }
        else {
            const float alr = AB[4096 + gn], ali = AB[6144 + gn];
            const f32x2* Ep = E + (size_t)((b * 32 + g) * 32) * 64 + n;
#pragma unroll 8
            for (int j = 0; j < seg; ++j) { const f32x2 e = Ep[(size_t)j * 64]; const float t = fmaf(alr, xr, fmaf(-ali, xi, e.x)); xi = fmaf(alr, xi, fmaf(ali, xr, e.y)); xr = t; }
        }
    }
    bf16x8 cm[4]; float dsk = 0.f;
    if (PASS == 2) {
        const bf16_t* CMT = (const bf16_t*)(ws + WS_CMT);
#pragma unroll
        for (int ks = 0; ks < 4; ++ks) cm[ks] = *(const bf16x8*)(CMT + (size_t)(g * 16 + c) * 128 + ks * 32 + q4 * 8);
        dsk = a.in[I_DSK][g * 16 + c];
    }
    const int tclamp = c < tcount ? c : tcount - 1;
    bf16x8 ucur = *(const bf16x8*)(U + (size_t)(row0 + tclamp) * 512 + g * 16 + 8 * (q4 & 1));
    bf16_t uscur[4];
    if (PASS == 2) {
#pragma unroll
        for (int i = 0; i < 4; ++i) { const int tok = 4 * q4 + i; uscur[i] = U[(size_t)(row0 + (tok < tcount ? tok : tcount - 1)) * 512 + g * 16 + c]; }
    }
#pragma unroll 1
    for (int blk = 0; blk < nblk; ++blk) {
        const int r0 = row0 + blk * 16;
        bf16x8 unext = zero8; bf16_t usnext[4] = {0, 0, 0, 0};
        if (blk + 1 < nblk) {
            unext = *(const bf16x8*)(U + (size_t)(r0 + 16 + c) * 512 + g * 16 + 8 * (q4 & 1));
            if (PASS == 2) {
#pragma unroll
                for (int i = 0; i < 4; ++i) usnext[i] = U[(size_t)(r0 + 16 + 4 * q4 + i) * 512 + g * 16 + c];
            }
        }
        f32x4 d[8];
#pragma unroll
        for (int vt = 0; vt < 8; ++vt) d[vt] = __builtin_amdgcn_mfma_f32_16x16x32_bf16(ucur, bb[vt], (f32x4){0.f, 0.f, 0.f, 0.f}, 0, 0, 0);
        asm volatile("s_nop 15" : "+v"(d[0]), "+v"(d[1]), "+v"(d[2]), "+v"(d[3]), "+v"(d[4]), "+v"(d[5]), "+v"(d[6]), "+v"(d[7]));
#pragma unroll
        for (int vt = 0; vt < 8; ++vt)
#pragma unroll
            for (int i = 0; i < 4; ++i) *(LAS float*)(bu + (4 * q4 + i) * BUP + (16 * vt + c) * 4) = d[vt][i];
        asm volatile("" :: "v"(ucur));
        asm volatile("s_waitcnt lgkmcnt(0)" ::: "memory");
#pragma unroll
        for (int tt = 0; tt < 16; ++tt) {
            if (tt < tcount) {
                const f32x2 v = *(const LAS f32x2*)(bu + tt * BUP + n * 8);
                const float nxr = fmaf(abr, xr, fmaf(-abi, xi, v.x)), nxi = fmaf(abr, xi, fmaf(abi, xr, v.y));
                xr = nxr; xi = nxi;
                if (PASS == 2) *(LAS unsigned*)(xl + tt * XP + n * 4) = cvt_pk(xr, xi);
            }
        }
        asm volatile("s_waitcnt lgkmcnt(0)" ::: "memory");
        if (PASS == 2) {
            bf16_t* Z = (bf16_t*)(ws + WS_Z);
            f32x4 acc = (f32x4){0.f, 0.f, 0.f, 0.f};
#pragma unroll
            for (int ks = 0; ks < 4; ++ks) {
                const bf16x8 af = *(const LAS bf16x8*)(xl + c * XP + ks * 64 + q4 * 16);
                acc = __builtin_amdgcn_mfma_f32_16x16x32_bf16(af, cm[ks], acc, 0, 0, 0);
            }
#pragma unroll
            for (int i = 0; i < 4; ++i) {
                const int tok = 4 * q4 + i;
                if (tok < tcount) {
                    const float y = acc[i] + dsk * bf2f(uscur[i]);
                    const float z = y * fast_sigmoid(1.5957691216057308f * (y + 0.044715f * y * y * y));
                    Z[(size_t)(r0 + tok) * 512 + g * 16 + c] = (bf16_t)(cvt_pk(z, 0.f) & 0xffff);
                }
            }
        }
        asm volatile("s_waitcnt lgkmcnt(0)" ::: "memory");
        ucur = unext;
#pragma unroll
        for (int i = 0; i < 4; ++i) uscur[i] = usnext[i];
    }
    if (PASS == 1) {
        const unsigned long long bits = ((unsigned long long)__float_as_uint(xi) << 32) | (unsigned long long)__float_as_uint(xr);
        __hip_atomic_store((unsigned long long*)(E + (size_t)((b * 32 + g) * 32 + seg) * 64 + n), bits, __ATOMIC_RELAXED, __HIP_MEMORY_SCOPE_AGENT);
    }
    else if (sample) { a.out[O_RES + (size_t)(b * 32 + g) * 64 + n] = xr; a.out[O_IMS + (size_t)(b * 32 + g) * 64 + n] = xi; }
    else if (seg == 31) { a.out[O_REP + (size_t)(b * 32 + g) * 64 + n] = xr; a.out[O_IMP + (size_t)(b * 32 + g) * 64 + n] = xi; }
}

constexpr size_t WS_BAR = 896 * KiB, BAR_BYTES = 16 * KiB;
#define XB_TMO      128
#define XB_XCNT(j)  (256  + 64 * (j))
#define XB_XSUB(j)  (1280 + 64 * (j))
#define XB_XGEN(j)  (2304 + 64 * (j))
#define XB_TOP      3328
#define XB_TOPGEN   3392
#define XB_SPIN_CAP (1u << 18)
__device__ __forceinline__ unsigned xb_ld(unsigned* p)              { return __hip_atomic_load(p, __ATOMIC_RELAXED, __HIP_MEMORY_SCOPE_AGENT); }
__device__ __forceinline__ unsigned xb_add(unsigned* p, unsigned v) { return __hip_atomic_fetch_add(p, v, __ATOMIC_RELAXED, __HIP_MEMORY_SCOPE_AGENT); }
__device__ __forceinline__ unsigned xb_xcc_id() { return (unsigned)__builtin_amdgcn_s_getreg((3 << 11) | 20) & 0xFu; }
#define XB_SPIN(cond, bar) do { unsigned _sp = 0; while (cond) { __builtin_amdgcn_s_sleep(1); \
    if ((++_sp & 255u) == 0u) { if (xb_ld(&(bar)[XB_TMO])) break; if (_sp > XB_SPIN_CAP) { atomicAdd(&(bar)[XB_TMO], 1u); break; } } } } while (0)
struct XcdBarrier { unsigned* bar; unsigned x; volatile LAS unsigned* st; };
__device__ __forceinline__ XcdBarrier xcd_barrier_post(unsigned* bar, volatile LAS unsigned* st) {
    XcdBarrier b; b.bar = bar; b.x = xb_xcc_id(); b.st = st;
    if (threadIdx.x == 0) (void)xb_add(&bar[XB_XCNT(b.x)], 1u);
    return b;
}
__device__ __forceinline__ void xcd_barrier_complete(unsigned* bar, unsigned x, unsigned& nloc, unsigned& nx) {
    const unsigned G = gridDim.x * gridDim.y * gridDim.z;
    unsigned sum, cnt, mine, sp = 0u;
    for (;;) {
        sum = 0u; cnt = 0u; mine = 0u;
#pragma unroll
        for (unsigned j = 0; j < 16; ++j) { const unsigned c = xb_ld(&bar[XB_XCNT(j)]); sum += c; cnt += (c > 0u) ? 1u : 0u; mine = (j == x) ? c : mine; }
        if (sum == G) break;
        __builtin_amdgcn_s_sleep(1);
        if ((++sp & 255u) == 0u) { if (xb_ld(&bar[XB_TMO])) break; if (sp > XB_SPIN_CAP) { atomicAdd(&bar[XB_TMO], 1u); break; } }
    }
    nloc = mine > 0u ? mine : 1u; nx = cnt > 0u ? cnt : 1u;
}
__device__ __forceinline__ void xcd_barrier(const XcdBarrier& b) {
    asm volatile("s_waitcnt vmcnt(0)" ::: "memory");
    __syncthreads();
    if (threadIdx.x == 0) {
        unsigned* bar = b.bar;
        __builtin_amdgcn_s_waitcnt(0);
        unsigned nloc = b.st[0], nx = b.st[1];
        if (nloc == 0u) { xcd_barrier_complete(bar, b.x, nloc, nx); b.st[0] = nloc; b.st[1] = nx; }
        const unsigned old = xb_add(&bar[XB_XSUB(b.x)], 1u);
        const unsigned gen = old / nloc;
        if (old + 1u == (gen + 1u) * nloc) {
            __builtin_amdgcn_fence(__ATOMIC_RELEASE, "agent");
            asm volatile("s_waitcnt vmcnt(0)" ::: "memory");
            const unsigned og = xb_add(&bar[XB_TOP], 1u);
            const unsigned tg = og / nx;
            if (og + 1u == (tg + 1u) * nx) xb_add(&bar[XB_TOPGEN], 1u);
            else XB_SPIN(xb_ld(&bar[XB_TOPGEN]) == tg, bar);
            __builtin_amdgcn_fence(__ATOMIC_ACQUIRE, "agent");
            xb_add(&bar[XB_XGEN(b.x)], 1u);
            asm volatile("s_waitcnt vmcnt(0)" ::: "memory");
        } else {
            XB_SPIN(xb_ld(&bar[XB_XGEN(b.x)]) == gen, bar);
            __builtin_amdgcn_fence(__ATOMIC_ACQUIRE, "agent");
            asm volatile("s_waitcnt vmcnt(0)" ::: "memory");
        }
    }
    __syncthreads();
}

__global__ void __launch_bounds__(512, 2) fwd_kernel(Args a) {
    extern __shared__ __attribute__((aligned(16))) unsigned char lds_raw[];
    LAS unsigned char* lds = (LAS unsigned char*)lds_raw;
    const int tid = threadIdx.x, lane = tid & 63, wave = __builtin_amdgcn_readfirstlane(tid >> 6), G = gridDim.x;
    unsigned char* ws = a.ws;
    const int lo = a.ph_lo, hi = a.ph_hi;
    cg::grid_group grid = cg::this_grid();
#ifndef PROBE_PHASE
#define PROBE_PHASE -1
#endif
#define IN(k) (lo <= (k) && (k) < hi)
#if PROBE_PHASE >= 0
#define PH_BEGIN(k) _Pragma("unroll 1") for (int _r = 0; _r < ((PROBE_PHASE) == (k) ? 2 : 1); ++_r) { if (IN(k)) {
#define PH_END(k) } SEAM(k); }
#else
#define PH_BEGIN(k) if (IN(k)) {
#define PH_END(k) } SEAM(k);
#endif
#define SEAM(k) do { if (IN(k) && IN((k) + 1)) { xcd_barrier(xbar); } } while (0)
    { volatile LAS unsigned* st = (volatile LAS unsigned*)(lds + LDS_BYTES - 64); if (tid == 0) { st[0] = 0u; st[1] = 0u; } __syncthreads(); }
    if (hi > 1000) grid.sync();
    const XcdBarrier xbar = xcd_barrier_post((unsigned*)(ws + WS_BAR), (volatile LAS unsigned*)(lds + LDS_BYTES - 64));
    bf16_t* XB = (bf16_t*)(ws + WS_XB); bf16_t* ACT = (bf16_t*)(ws + WS_ACT);
    float* Y = a.out + O_Y;

    PH_BEGIN(0) prologue(a, lds, tid, lane, wave, G); PH_END(0)
    PH_BEGIN(1)
        pg8::Gemm g{XB, (const bf16_t*)(ws + WS_W13A), M, 2 * FF, D, D, D}; pg8::StaticOrder S; S.init(M, 2 * FF, G, (int)blockIdx.x);
        EpiSwiglu E{ACT, (const float*)(ws + WS_RS0), 0};
        pg8::gemm_phase(lds, g, S, E);
    PH_END(1)
    PH_BEGIN(2)
        pg8::Gemm g{ACT, (const bf16_t*)(ws + WS_W2A), MP, D, FF, FF, FF}; pg8::StaticOrder S; S.init(MP, D, G, (int)blockIdx.x);
        EpiResid E{a.in[I_XP], a.in[I_XS], nullptr, nullptr, XB, (float*)(ws + WS_SS1), 0.5f};
        if (blockIdx.x & 1) for (int tile = blockIdx.x; tile < 256; tile += G) tail_gemm(lds, ACT + (size_t)MP * FF, FF, (const bf16_t*)(ws + WS_W2A), FF, FF, tile, E, tid, lane, wave);
        pg8::gemm_phase(lds, g, S, E);
        if (!(blockIdx.x & 1)) for (int tile = blockIdx.x; tile < 256; tile += G) tail_gemm(lds, ACT + (size_t)MP * FF, FF, (const bf16_t*)(ws + WS_W2A), FF, FF, tile, E, tid, lane, wave);
    PH_END(2)
    PH_BEGIN(3)
        pg8::Gemm g{XB, (const bf16_t*)(ws + WS_WIN), M, NIN, D, D, D}; pg8::StaticOrder S; S.init(M, NIN, G, (int)blockIdx.x);
        EpiProj E{(const float*)(ws + WS_SS1), ws, a.in[I_QN], a.in[I_KN], a.out};
        pg8::gemm_phase(lds, g, S, E);
    PH_END(3)
    PH_BEGIN(4)
        for (int unit = blockIdx.x; unit < 512; unit += G) attn_unit(a, lds, unit, tid, lane, wave);
        for (int bi = blockIdx.x; bi < 256; bi += G) ssm_item<1>(a, lds + wave * SSM_WLDS, bi >> 7, ((bi >> 5) & 3) * 8 + wave, bi & 31, false, lane);
        {
            const int gt = blockIdx.x * 512 + tid, NGT = G * 512;
            for (int i0 = gt; i0 < 2 * 128 * 3968; i0 += 4 * NGT) {
                f32x4 v[4];
#pragma unroll
                for (int j = 0; j < 4; ++j) { const int i = i0 + j * NGT; if (i < 2 * 128 * 3968) { const int which = i / (128 * 3968), r = i % (128 * 3968), b = r / 3968, o = r % 3968;
                    v[j] = __builtin_nontemporal_load((const f32x4*)(a.in[which ? I_CV : I_CK] + (size_t)b * 16384 + 512) + o); } }
#pragma unroll
                for (int j = 0; j < 4; ++j) { const int i = i0 + j * NGT; if (i < 2 * 128 * 3968) { const int which = i / (128 * 3968), r = i % (128 * 3968), b = r / 3968, o = r % 3968;
                    __builtin_nontemporal_store(v[j], (f32x4*)(a.out + (which ? O_VS : O_KS) + (size_t)b * 16384) + o); } }
            }
        }
        __syncthreads();
    PH_END(4)
    PH_BEGIN(5)
        LAS unsigned char* xl = lds + wave * SSM_WLDS;
        for (int bi = blockIdx.x; bi < 256 + 512; bi += G) {
            if (bi < 256) ssm_item<2>(a, xl, bi >> 7, ((bi >> 5) & 3) * 8 + wave, bi & 31, false, lane);
            else { const int si = bi - 256; ssm_item<2>(a, xl, si >> 2, (si & 3) * 8 + wave, 0, true, lane); }
        }
        __syncthreads();
    PH_END(5)
    PH_BEGIN(6)
        {
            pg8::Gemm g{(const bf16_t*)(ws + WS_Z), (const bf16_t*)(ws + WS_WGLU), M, 512, 512, 512, 512}; pg8::StaticOrder S; S.init(M, 512, G, (int)blockIdx.x);
            EpiGlu E{(const bf16_t*)(ws + WS_Z), a.in[I_BGLU], (bf16_t*)(ws + WS_SSMB)};
            pg8::gemm_phase(lds, g, S, E);
        }
        {
            pg8::Gemm g{(const bf16_t*)(ws + WS_ATTN), (const bf16_t*)(ws + WS_WAO), MP, D, 512, 512, 512}; pg8::StaticOrder S; S.init(MP, D, G, (int)((blockIdx.x + G - 132 % G) % G));
            EpiGate<false> E{(const bf16_t*)(ws + WS_GA), (bf16_t*)(ws + WS_MERGED)};
            if (blockIdx.x & 1) for (int tile = blockIdx.x; tile < 256; tile += G) tail_gemm(lds, (const bf16_t*)(ws + WS_ATTN) + (size_t)MP * 512, 512, (const bf16_t*)(ws + WS_WAO), 512, 512, tile, E, tid, lane, wave);
            pg8::gemm_phase(lds, g, S, E);
            if (!(blockIdx.x & 1)) for (int tile = blockIdx.x; tile < 256; tile += G) tail_gemm(lds, (const bf16_t*)(ws + WS_ATTN) + (size_t)MP * 512, 512, (const bf16_t*)(ws + WS_WAO), 512, 512, tile, E, tid, lane, wave);
        }
    PH_END(6)
    PH_BEGIN(7)
        pg8::Gemm g{(const bf16_t*)(ws + WS_SSMB), (const bf16_t*)(ws + WS_WSO), MP, D, 512, 512, 512}; pg8::StaticOrder S; S.init(MP, D, G, (int)blockIdx.x);
        EpiGate<true> E{(const bf16_t*)(ws + WS_GS), (bf16_t*)(ws + WS_MERGED)};
        if (blockIdx.x & 1) for (int tile = blockIdx.x; tile < 256; tile += G) tail_gemm(lds, (const bf16_t*)(ws + WS_SSMB) + (size_t)MP * 512, 512, (const bf16_t*)(ws + WS_WSO), 512, 512, tile, E, tid, lane, wave);
        pg8::gemm_phase(lds, g, S, E);
        if (!(blockIdx.x & 1)) for (int tile = blockIdx.x; tile < 256; tile += G) tail_gemm(lds, (const bf16_t*)(ws + WS_SSMB) + (size_t)MP * 512, 512, (const bf16_t*)(ws + WS_WSO), 512, 512, tile, E, tid, lane, wave);
    PH_END(7)
    PH_BEGIN(8)
        pg8::Gemm g{(const bf16_t*)(ws + WS_MERGED), (const bf16_t*)(ws + WS_WOUT), MP, D, D, D, D}; pg8::StaticOrder S; S.init(MP, D, G, (int)blockIdx.x);
        EpiResid E{nullptr, nullptr, XB, nullptr, XB, (float*)(ws + WS_SS2), 1.0f};
        if (blockIdx.x & 1) for (int tile = blockIdx.x; tile < 256; tile += G) tail_gemm(lds, (const bf16_t*)(ws + WS_MERGED) + (size_t)MP * D, D, (const bf16_t*)(ws + WS_WOUT), D, D, tile, E, tid, lane, wave);
        pg8::gemm_phase(lds, g, S, E);
        if (!(blockIdx.x & 1)) for (int tile = blockIdx.x; tile < 256; tile += G) tail_gemm(lds, (const bf16_t*)(ws + WS_MERGED) + (size_t)MP * D, D, (const bf16_t*)(ws + WS_WOUT), D, D, tile, E, tid, lane, wave);
    PH_END(8)
    PH_BEGIN(9)
        pg8::Gemm g{XB, (const bf16_t*)(ws + WS_W13B), M, 2 * FF, D, D, D}; pg8::StaticOrder S; S.init(M, 2 * FF, G, (int)blockIdx.x);
        EpiSwiglu E{ACT, (const float*)(ws + WS_SS2), 1};
        pg8::gemm_phase(lds, g, S, E);
    PH_END(9)
    if (IN(10)) {
        pg8::Gemm g{ACT, (const bf16_t*)(ws + WS_W2B), MP, D, FF, FF, FF}; pg8::StaticOrder S; S.init(MP, D, G, (int)blockIdx.x);
        EpiResid E{nullptr, nullptr, XB, Y, nullptr, nullptr, 0.5f};
        if (blockIdx.x & 1) for (int tile = blockIdx.x; tile < 256; tile += G) tail_gemm(lds, ACT + (size_t)MP * FF, FF, (const bf16_t*)(ws + WS_W2B), FF, FF, tile, E, tid, lane, wave);
        pg8::gemm_phase(lds, g, S, E);
        if (!(blockIdx.x & 1)) for (int tile = blockIdx.x; tile < 256; tile += G) tail_gemm(lds, ACT + (size_t)MP * FF, FF, (const bf16_t*)(ws + WS_W2B), FF, FF, tile, E, tid, lane, wave);
    }
#undef IN
#undef SEAM
}

#ifndef PROBE_CUT
#define PROBE_CUT -1
#endif
#ifndef PROBE_REP
#define PROBE_REP 0
#endif
extern "C" void kernel_launch(void* const* d_in, const int* in_sizes, int n_in, void* d_out, int out_size, void* d_ws, size_t ws_size, hipStream_t stream) {
    static int grid = 0;
    if (grid == 0) {
        if (n_in != 32 || ws_size < WS_END) { fprintf(stderr, "kernel_launch: unexpected n_in %d / ws_size %zu\n", n_in, ws_size); grid = -1; return; }
        int dev = 0, cus = 0, per_cu = 0;
        hipGetDevice(&dev); hipDeviceGetAttribute(&cus, hipDeviceAttributeMultiprocessorCount, dev);
        hipFuncSetAttribute((const void*)fwd_kernel, hipFuncAttributeMaxDynamicSharedMemorySize, LDS_BYTES);
        hipOccupancyMaxActiveBlocksPerMultiprocessor(&per_cu, (const void*)fwd_kernel, 512, LDS_BYTES);
        (void)hipGetLastError();
        if (per_cu < 1) per_cu = 1;
        grid = cus * 1;
    }
    if (grid < 0) return;
    Args a{};
    for (int i = 0; i < 32; ++i) a.in[i] = (const float*)d_in[i];
    a.out = (float*)d_out; a.ws = (unsigned char*)d_ws;
    (void)hipMemsetAsync((char*)d_ws + WS_BAR, 0, BAR_BYTES, stream);
#if PROBE_CUT >= 0
    { a.ph_lo = 0; a.ph_hi = PROBE_CUT + PROBE_REP; void* args[] = {&a};
      hipLaunchCooperativeKernel((const void*)fwd_kernel, dim3(grid), dim3(512), args, LDS_BYTES, stream); }
    (void)hipMemsetAsync((char*)d_ws + WS_BAR, 0, BAR_BYTES, stream);
    { a.ph_lo = PROBE_CUT; a.ph_hi = 11; void* args[] = {&a};
      hipLaunchCooperativeKernel((const void*)fwd_kernel, dim3(grid), dim3(512), args, LDS_BYTES, stream); }
#else
    a.ph_lo = 0; a.ph_hi = 11; void* args[] = {&a};
    hipError_t e = hipLaunchCooperativeKernel((const void*)fwd_kernel, dim3(grid), dim3(512), args, LDS_BYTES, stream);
    if (e != hipSuccess) fprintf(stderr, "cooperative launch failed: %s (grid %d)\n", hipGetErrorString(e), grid);
#endif
}
```

```cpp
#include <hip/hip_runtime.h>
#include <hip/hip_cooperative_groups.h>
#include <cstdio>
#include <cstdint>
namespace cg = cooperative_groups;

#define LAS __attribute__((address_space(3)))
typedef unsigned short bf16_t;
typedef short bf16x8 __attribute__((ext_vector_type(8)));
typedef float f32x4 __attribute__((ext_vector_type(4)));
typedef float f32x2 __attribute__((ext_vector_type(2)));
typedef float f32x16 __attribute__((ext_vector_type(16)));
typedef unsigned u32x4 __attribute__((ext_vector_type(4)));
typedef unsigned u32x2 __attribute__((ext_vector_type(2)));
typedef __bf16 bf16x2_t __attribute__((ext_vector_type(2)));

constexpr int D = 1024, FF = 2816, NIN = 3328;
constexpr int MP = 16384, MS = 512, M = MP + MS;
constexpr int SEQ = 8192, PAST = 16384;
constexpr float EPS = 1e-6f;
constexpr float LOG2E = 1.4426950408889634f;
constexpr size_t O_Y = 0, O_KP = 17301504, O_VP = 17334272, O_REP = 17367040, O_IMP = 17371136,
                 O_KS = 17375232, O_VS = 19472384, O_RES = 21569536, O_IMS = 21831680;
constexpr size_t KiB = 1024, MiB = 1024 * 1024;
constexpr size_t WS_RS0 = 0, WS_SS1 = 128 * KiB, WS_SS2 = 256 * KiB, WS_AB = 384 * KiB, WS_BBR = 512 * KiB, WS_BBI = 640 * KiB, WS_CMT = 768 * KiB;
constexpr size_t WS_E = 1 * MiB, WS_BBT = 3 * MiB;
constexpr size_t WS_W13A = 8 * MiB, WS_W2A = 19 * MiB, WS_WIN = WS_W2A + 5632 * KiB, WS_WGLU = 31 * MiB, WS_WAO = WS_WGLU + 512 * KiB, WS_WSO = WS_WAO + MiB,
                 WS_WOUT = WS_WSO + MiB, WS_W13B = WS_WOUT + 2 * MiB, WS_W2B = WS_W13B + 11 * MiB;
constexpr size_t WS_XB = 52 * MiB;
constexpr size_t WS_ACT = 85 * MiB;
constexpr size_t WS_Q = 85 * MiB, WS_K = WS_Q + (size_t)M * 512 * 2, WS_V = WS_K + (size_t)M * 128 * 2, WS_U = WS_V + (size_t)M * 128 * 2,
                 WS_GA = WS_U + (size_t)M * 512 * 2, WS_GS = WS_GA + (size_t)M * 1024 * 2;
constexpr size_t WS_MERGED = 85 * MiB;
constexpr size_t WS_ATTN = 193 * MiB, WS_Z = WS_ATTN + (size_t)M * 512 * 2, WS_SSMB = WS_Z + (size_t)M * 512 * 2, WS_END = WS_SSMB + (size_t)M * 512 * 2;
static_assert(WS_W2B + 5632 * KiB <= WS_XB && WS_XB + (size_t)M * 1024 * 2 <= WS_ACT && WS_GS + (size_t)M * 1024 * 2 <= WS_ATTN && WS_ACT + (size_t)M * FF * 2 <= WS_ATTN &&
              WS_END <= 256 * MiB && WS_WIN + (size_t)NIN * 1024 * 2 <= WS_WGLU && WS_E + 4 * MiB <= WS_W13A, "ws map");

constexpr int LDS_BYTES = 147456;

__device__ __forceinline__ unsigned cvt_pk(float lo, float hi) { f32x2 v = {lo, hi}; bf16x2_t b = __builtin_convertvector(v, bf16x2_t); return __builtin_bit_cast(unsigned, b); }
__device__ __forceinline__ float bf_lo(unsigned w) { return __uint_as_float(w << 16); }
__device__ __forceinline__ float bf_hi(unsigned w) { return __uint_as_float(w & 0xffff0000u); }
__device__ __forceinline__ float bf2f(bf16_t b) { return __uint_as_float((unsigned)b << 16); }
__device__ __forceinline__ void unpack8(u32x4 w, float* f) { f[0] = bf_lo(w.x); f[1] = bf_hi(w.x); f[2] = bf_lo(w.y); f[3] = bf_hi(w.y); f[4] = bf_lo(w.z); f[5] = bf_hi(w.z); f[6] = bf_lo(w.w); f[7] = bf_hi(w.w); }
__device__ __forceinline__ u32x4 pack8(const float* f) { u32x4 w; w.x = cvt_pk(f[0], f[1]); w.y = cvt_pk(f[2], f[3]); w.z = cvt_pk(f[4], f[5]); w.w = cvt_pk(f[6], f[7]); return w; }
__device__ __forceinline__ float fast_sigmoid(float x) { return __builtin_amdgcn_rcpf(1.f + __builtin_amdgcn_exp2f(-LOG2E * x)); }
__device__ __forceinline__ float wave_sum(float v) {
#pragma unroll
    for (int o = 1; o < 64; o <<= 1) v += __shfl_xor(v, o);
    return v;
}

namespace pg8 {
constexpr int BM = 256, BK = 64, HALF = 128, HTB = HALF * BK * 2, STAGE_BYTES = 8 * HTB, NXCD = 8, WGM = 8;
__host__ __device__ __forceinline__ int lds_byte(int r, int c) { const int st = (r >> 4) * 2 + (c >> 5), rr = r & 15, cc = c & 31, ob = rr * 64 + cc * 2; return st * 1024 + (ob ^ (((ob >> 9) & 1) << 5)); }
__host__ __device__ __forceinline__ void stage_rc(int b, int& R, int& C) { const int st = b / 1024, sb = b % 1024, swz = sb ^ (((sb >> 9) & 1) << 5); R = (st >> 1) * 16 + swz / 64; C = (st & 1) * 32 + (swz % 64) / 2; }
__host__ __device__ __forceinline__ int perm32(int rho) { const int n = rho >> 4, i = rho & 15; return 8 * (i >> 2) + 4 * n + (i & 3); }

struct Unit { int pm, pn; };
struct Gemm { const bf16_t* A; const bf16_t* Bt; int M, N, K, lda, ldb; };

struct StaticOrder {
    int nM, nN, nwg, G, c;
    __host__ __device__ void init(int M_, int N_, int G_, int c_) { nM = M_ / BM; nN = N_ / BM; nwg = nM * nN; G = G_; c = c_; }
    __host__ __device__ bool next(int i, Unit& u) const {
        const long L = (long)i * G + c; if (L >= nwg) return false;
        int wgid = (int)L; { const int q = nwg / NXCD, r = nwg % NXCD, xcd = wgid % NXCD, off = wgid / NXCD; wgid = (xcd < r ? xcd * (q + 1) : r * (q + 1) + (xcd - r) * q) + off; }
        const int nig = WGM * nN, gid = wgid / nig, fm = gid * WGM, gsz = (nM - fm) < WGM ? (nM - fm) : WGM;
        u.pm = fm + ((wgid % nig) % gsz); u.pn = (wgid % nig) / gsz; return true;
    }
};

template <class Epi, class Sched, bool ALIGN_EPI = true, bool SP2 = true>
__device__ __forceinline__ void gemm_phase(LAS unsigned char* lds, const Gemm g, const Sched& S, const Epi& E) {
    const int tid = threadIdx.x, wid = __builtin_amdgcn_readfirstlane(tid >> 6), lane = tid & 63, wr = wid >> 2, wc = wid & 3, fr = lane & 15, fq = lane >> 4;
    const int K = g.K, nt = K / BK;
    unsigned voffA[2], voffB[2];
#pragma unroll
    for (int i = 0; i < 2; ++i) { int R, C; stage_rc(tid * 16 + i * 8192, R, C); const int Rb = Epi::PERM ? ((R & ~31) + perm32(R & 31)) : R;
        voffA[i] = (unsigned)(R * g.lda + C) * 2u; voffB[i] = (unsigned)(Rb * g.ldb + C) * 2u; }
    const size_t kstep = (size_t)(BK * 2);
    const size_t hstepA = (size_t)HALF * g.lda * 2, hstepB = (size_t)HALF * g.ldb * 2;
    const size_t tstepA = 2 * hstepA, tstepB = 2 * hstepB;
    const unsigned ldsw = (unsigned)wid * 1024u;
    const int aoff = lds_byte(wr * 64 + fr, fq * 8), boff = lds_byte(wc * 32 + fr, fq * 8);
#define PG8_SA(b, h) (((b) * 2 + (h)) * HTB)
#define PG8_SB(b, h) ((4 + (b) * 2 + (h)) * HTB)
#define PG8_STAGE(bufoff, gbase, voff) do { _Pragma("unroll") for (int _i = 0; _i < 2; ++_i) \
        __builtin_amdgcn_global_load_lds((const unsigned*)((const char*)(gbase) + (voff)[_i]), (LAS unsigned*)(lds + (bufoff) + ldsw + _i * 8192), 16, 0, 0); } while (0)
#define PG8_LDA(dst, b, h) do { _Pragma("unroll") for (int m = 0; m < 4; ++m) _Pragma("unroll") for (int k = 0; k < 2; ++k) dst[m][k] = *(const LAS bf16x8*)(lds + PG8_SA(b, h) + aoff + m * 2048 + k * 1024); } while (0)
#define PG8_LDB(dst, b, h) do { _Pragma("unroll") for (int n = 0; n < 2; ++n) _Pragma("unroll") for (int k = 0; k < 2; ++k) dst[n][k] = *(const LAS bf16x8*)(lds + PG8_SB(b, h) + boff + n * 2048 + k * 1024); } while (0)
#define PG8_MMA(ai, bj, At, Bt) do { __builtin_amdgcn_s_setprio(1); _Pragma("unroll") for (int m = 0; m < 4; ++m) _Pragma("unroll") for (int n = 0; n < 2; ++n) _Pragma("unroll") for (int k = 0; k < 2; ++k) \
        acc[ai][bj][m][n] = __builtin_amdgcn_mfma_f32_16x16x32_bf16(Bt[n][k], At[m][k], acc[ai][bj][m][n], 0, 0, 0); __builtin_amdgcn_s_setprio(0); } while (0)
#define PG8_WAIT_V(n) asm volatile("s_waitcnt vmcnt(" #n ")" ::: "memory")
#define PG8_WAIT_L(n) asm volatile("s_waitcnt lgkmcnt(" #n ")" ::: "memory")
#define PG8_BAR __builtin_amdgcn_s_barrier()
#define PG8_SCHED __builtin_amdgcn_sched_barrier(0)
    Unit cur, nxt; int ui = 0;
    if (!S.next(0, cur)) return;
    f32x4 acc[2][2][4][2];
#pragma unroll
    for (int a = 0; a < 2; ++a)
#pragma unroll
        for (int b = 0; b < 2; ++b)
#pragma unroll
            for (int m = 0; m < 4; ++m)
#pragma unroll
                for (int n = 0; n < 2; ++n) acc[a][b][m][n] = (f32x4){0.f, 0.f, 0.f, 0.f};
    bf16x8 At[4][2], B0[2][2], B1[2][2];
    const char* cA = (const char*)g.A + (size_t)cur.pm * tstepA; const char* cB = (const char*)g.Bt + (size_t)cur.pn * tstepB;
    {
        PG8_STAGE(PG8_SB(0, 0), cB, voffB); PG8_STAGE(PG8_SB(0, 1), cB + hstepB, voffB); PG8_STAGE(PG8_SA(0, 0), cA, voffA); PG8_STAGE(PG8_SA(0, 1), cA + hstepA, voffA);
        if (wr == 1) PG8_BAR;
        PG8_WAIT_V(2); PG8_BAR;
        PG8_STAGE(PG8_SB(1, 0), cB + kstep, voffB); PG8_STAGE(PG8_SA(1, 0), cA + kstep, voffA); PG8_STAGE(PG8_SB(1, 1), cB + hstepB + kstep, voffB);
        PG8_WAIT_V(6); PG8_BAR;
    }
    for (;;) {
        const bool has_next = S.next(ui + 1, nxt);
        const char* nA = has_next ? (const char*)g.A + (size_t)nxt.pm * tstepA : cA; const char* nB = has_next ? (const char*)g.Bt + (size_t)nxt.pn * tstepB : cB;
        for (int t = 0; t < nt; t += 2) {
            const bool last = (t == nt - 2);
            const char* a1 = cA + (size_t)(t + 1) * kstep;
            const char* a2 = last ? nA : cA + (size_t)(t + 2) * kstep; const char* b2 = last ? nB : cB + (size_t)(t + 2) * kstep;
            const char* a3 = a2 + kstep; const char* b3 = b2 + kstep;
            PG8_LDB(B0, 0, 0); PG8_LDB(B1, 0, 1); PG8_SCHED; PG8_LDA(At, 0, 0); PG8_STAGE(PG8_SA(1, 1), a1 + hstepA, voffA);
            PG8_WAIT_V(8); PG8_WAIT_L(0); PG8_BAR; PG8_MMA(0, 0, At, B0); PG8_MMA(0, 1, At, B1); PG8_BAR; PG8_SCHED;
            PG8_LDA(At, 0, 1); PG8_STAGE(PG8_SB(0, 0), b2, voffB); PG8_STAGE(PG8_SB(0, 1), b2 + hstepB, voffB); PG8_STAGE(PG8_SA(0, 0), a2, voffA);
            PG8_WAIT_V(8); PG8_WAIT_L(0); PG8_BAR; PG8_MMA(1, 0, At, B0); PG8_MMA(1, 1, At, B1); PG8_BAR; PG8_SCHED;
            PG8_LDB(B0, 1, 0); PG8_LDB(B1, 1, 1); PG8_SCHED; PG8_LDA(At, 1, 0); PG8_STAGE(PG8_SA(0, 1), a2 + hstepA, voffA);
            PG8_WAIT_V(8); PG8_WAIT_L(0); PG8_BAR; PG8_MMA(0, 0, At, B0); PG8_MMA(0, 1, At, B1); PG8_BAR; PG8_SCHED;
            PG8_LDA(At, 1, 1); PG8_STAGE(PG8_SB(1, 0), b3, voffB); PG8_STAGE(PG8_SB(1, 1), b3 + hstepB, voffB); PG8_STAGE(PG8_SA(1, 0), a3, voffA);
            PG8_WAIT_V(8); PG8_WAIT_L(0); PG8_BAR; PG8_MMA(1, 0, At, B0); PG8_MMA(1, 1, At, B1); PG8_BAR; PG8_SCHED;
        }
        if constexpr (ALIGN_EPI) { if (wr == 0) PG8_BAR; }
        E(acc, cur, wr, wc, fr, fq);
        if (!has_next) break;
#pragma unroll
        for (int a = 0; a < 2; ++a)
#pragma unroll
            for (int b = 0; b < 2; ++b)
#pragma unroll
                for (int m = 0; m < 4; ++m)
#pragma unroll
                    for (int n = 0; n < 2; ++n) acc[a][b][m][n] = (f32x4){0.f, 0.f, 0.f, 0.f};
        cur = nxt; cA = nA; cB = nB; ++ui;
        if constexpr (ALIGN_EPI) { if (wr == 1) PG8_BAR; }
    }
    PG8_WAIT_V(0);
    if constexpr (!ALIGN_EPI) { if (wr == 0) PG8_BAR; }
    PG8_BAR;
#undef PG8_SA
#undef PG8_SB
#undef PG8_STAGE
#undef PG8_LDA
#undef PG8_LDB
#undef PG8_MMA
#undef PG8_WAIT_V
#undef PG8_WAIT_L
#undef PG8_BAR
#undef PG8_SCHED
}
}
using pg8::Unit;
typedef f32x4 AccT[2][2][4][2];

struct EpiSwiglu {
    static constexpr bool PERM = true;
    bf16_t* O; const float* rs; int rsmode;
    __device__ __forceinline__ void operator()(const AccT& acc, const Unit& u, int wr, int wc, int fr, int fq) const {
#pragma unroll
        for (int ai = 0; ai < 2; ++ai)
#pragma unroll
            for (int m = 0; m < 4; ++m) {
                const int row = u.pm * 256 + ai * 128 + wr * 64 + m * 16 + fr;
                float s = rs[row]; if (rsmode) s = rsqrtf(s * (1.f / 1024.f) + EPS);
                float o[8];
#pragma unroll
                for (int n = 0; n < 2; ++n)
#pragma unroll
                    for (int j = 0; j < 4; ++j) { const float a = acc[ai][0][m][n][j] * s, b = acc[ai][1][m][n][j] * s; o[n * 4 + j] = a * b * fast_sigmoid(a); }
                *(u32x4*)(O + (size_t)row * FF + u.pn * 128 + wc * 32 + fq * 8) = pack8(o);
            }
    }
};
struct EpiResid {
    static constexpr bool PERM = true;
    const float* base_p; const float* base_s; const bf16_t* base_b; float* out; bf16_t* xb; float* ss; float scale;
    __device__ __forceinline__ void operator()(const AccT& acc, const Unit& u, int wr, int wc, int fr, int fq) const {
#pragma unroll
        for (int ai = 0; ai < 2; ++ai)
#pragma unroll
            for (int m = 0; m < 4; ++m) {
                const int row = u.pm * 256 + ai * 128 + wr * 64 + m * 16 + fr;
                const float* bp = row < MP ? base_p + (size_t)row * D : base_s + (size_t)(row - MP) * D;
                float part = 0.f;
#pragma unroll
                for (int bj = 0; bj < 2; ++bj) {
                    const int c0 = u.pn * 256 + bj * 128 + wc * 32 + fq * 8;
                    f32x4 b0, b1;
                    if (base_b) { float t[8]; unpack8(*(const u32x4*)(base_b + (size_t)row * D + c0), t); b0 = (f32x4){t[0], t[1], t[2], t[3]}; b1 = (f32x4){t[4], t[5], t[6], t[7]}; }
                    else { b0 = __builtin_nontemporal_load((const f32x4*)(bp + c0)); b1 = __builtin_nontemporal_load((const f32x4*)(bp + c0 + 4)); }
                    const f32x4 o0 = b0 + acc[ai][bj][m][0] * scale, o1 = b1 + acc[ai][bj][m][1] * scale;
                    if (out) { __builtin_nontemporal_store(o0, (f32x4*)(out + (size_t)row * D + c0)); __builtin_nontemporal_store(o1, (f32x4*)(out + (size_t)row * D + c0 + 4)); }
                    if (xb) { u32x4 w; w.x = cvt_pk(o0[0], o0[1]); w.y = cvt_pk(o0[2], o0[3]); w.z = cvt_pk(o1[0], o1[1]); w.w = cvt_pk(o1[2], o1[3]); *(u32x4*)(xb + (size_t)row * D + c0) = w; }
                    part += (o0[0] * o0[0] + o0[1] * o0[1]) + (o0[2] * o0[2] + o0[3] * o0[3]) + (o1[0] * o1[0] + o1[1] * o1[1]) + (o1[2] * o1[2] + o1[3] * o1[3]);
                }
                if (ss) { part += __shfl_xor(part, 16); part += __shfl_xor(part, 32); if (fq == 0) unsafeAtomicAdd(ss + row, part); }
            }
    }
    __device__ __forceinline__ void tail(f32x4 v, int row, int col, int lane) const {
        f32x4 bv;
        if (base_b) { const u32x2 w = *(const u32x2*)(base_b + (size_t)row * D + col); bv = (f32x4){bf_lo(w.x), bf_hi(w.x), bf_lo(w.y), bf_hi(w.y)}; }
        else bv = *(const f32x4*)(base_s + (size_t)(row - MP) * D + col);
        const f32x4 o = bv + v * scale;
        if (out) *(f32x4*)(out + (size_t)row * D + col) = o;
        if (xb) { u32x2 w; w.x = cvt_pk(o[0], o[1]); w.y = cvt_pk(o[2], o[3]); *(u32x2*)(xb + (size_t)row * D + col) = w; }
        if (ss) { float part = (o[0] * o[0] + o[1] * o[1]) + (o[2] * o[2] + o[3] * o[3]);
            part += __shfl_xor(part, 1); part += __shfl_xor(part, 2); part += __shfl_xor(part, 4); part += __shfl_xor(part, 8);
            if ((lane & 15) == 0) unsafeAtomicAdd(ss + row, part); }
    }
};
struct EpiProj {
    static constexpr bool PERM = true;
    const float* ss1; unsigned char* ws; const float* gq; const float* gk; float* out;
    __device__ __forceinline__ void operator()(const AccT& acc, const Unit& u, int wr, int wc, int fr, int fq) const {
        const int pn = u.pn;
        if (pn <= 2) {
            const bool is_v = (pn == 2 && wc >= 2), is_q = pn < 2;
            const float* g = is_q ? gq : gk;
            float g1[8], g2[8], invf[8];
#pragma unroll
            for (int i = 0; i < 8; ++i) { g1[i] = g[fq * 8 + i]; g2[i] = g[32 + fq * 8 + i]; invf[i] = __builtin_amdgcn_exp2f(-(float)(fq * 8 + i) * 0.41524101186092029f) * 0.15915494309189535f; }
            const float osc = is_q ? 0.125f * LOG2E : 1.f;
#pragma unroll
            for (int ai = 0; ai < 2; ++ai)
#pragma unroll
                for (int m = 0; m < 4; ++m) {
                    const int row = u.pm * 256 + ai * 128 + wr * 64 + m * 16 + fr;
                    const float s = rsqrtf(ss1[row] * (1.f / 1024.f) + EPS);
                    float x1[8], x2[8];
#pragma unroll
                    for (int n = 0; n < 2; ++n)
#pragma unroll
                        for (int j = 0; j < 4; ++j) { x1[n * 4 + j] = acc[ai][0][m][n][j] * s; x2[n * 4 + j] = acc[ai][1][m][n][j] * s; }
                    if (!is_v) {
                        float q = 0.f;
#pragma unroll
                        for (int i = 0; i < 8; ++i) q += x1[i] * x1[i] + x2[i] * x2[i];
                        q += __shfl_xor(q, 16); q += __shfl_xor(q, 32);
                        const float inv = rsqrtf(q * (1.f / 64.f) + EPS);
                        const float pos = row < MP ? (float)(row & (SEQ - 1)) : (float)(PAST + ((row - MP) & 3));
#pragma unroll
                        for (int i = 0; i < 8; ++i) {
                            const float a = x1[i] * inv * g1[i], b = x2[i] * inv * g2[i];
                            float rev = pos * invf[i]; rev = rev - floorf(rev);
                            const float sn = __builtin_amdgcn_sinf(rev), cs = __builtin_amdgcn_cosf(rev);
                            x1[i] = (a * cs - b * sn) * osc; x2[i] = (b * cs + a * sn) * osc;
                        }
                    }
                    if (is_q) {
                        bf16_t* dst = (bf16_t*)(ws + WS_Q) + (size_t)row * 512 + (4 * pn + wc) * 64 + fq * 8;
                        *(u32x4*)dst = pack8(x1); *(u32x4*)(dst + 32) = pack8(x2);
                    } else {
                        const int kvh = wc & 1;
                        bf16_t* dst = (bf16_t*)(ws + (is_v ? WS_V : WS_K)) + (size_t)row * 128 + kvh * 64 + fq * 8;
                        *(u32x4*)dst = pack8(x1); *(u32x4*)(dst + 32) = pack8(x2);
                        float* od = nullptr;
                        if (row >= MP) { const int sr = row - MP, b = sr >> 2, t = sr & 3; od = out + (is_v ? O_VS : O_KS) + ((size_t)(b * 128 + 124 + t) * 2 + kvh) * 64 + fq * 8; }
                        else if ((row & (SEQ - 1)) >= SEQ - 128) { const int b = row >> 13, w = (row & (SEQ - 1)) - (SEQ - 128); od = out + (is_v ? O_VP : O_KP) + ((size_t)(b * 128 + w) * 2 + kvh) * 64 + fq * 8; }
                        if (od) {
                            __builtin_nontemporal_store((f32x4){x1[0], x1[1], x1[2], x1[3]}, (f32x4*)od); __builtin_nontemporal_store((f32x4){x1[4], x1[5], x1[6], x1[7]}, (f32x4*)(od + 4));
                            __builtin_nontemporal_store((f32x4){x2[0], x2[1], x2[2], x2[3]}, (f32x4*)(od + 32)); __builtin_nontemporal_store((f32x4){x2[4], x2[5], x2[6], x2[7]}, (f32x4*)(od + 36));
                        }
                    }
                }
        } else {
            const bool is_u = pn <= 4;
            size_t dofs; int ld, ct;
            if (is_u) { dofs = WS_U; ld = 512; ct = pn - 3; } else if (pn <= 8) { dofs = WS_GA; ld = 1024; ct = pn - 5; } else { dofs = WS_GS; ld = 1024; ct = pn - 9; }
            bf16_t* dstb = (bf16_t*)(ws + dofs);
#pragma unroll
            for (int ai = 0; ai < 2; ++ai)
#pragma unroll
                for (int m = 0; m < 4; ++m) {
                    const int row = u.pm * 256 + ai * 128 + wr * 64 + m * 16 + fr;
                    const float s = rsqrtf(ss1[row] * (1.f / 1024.f) + EPS);
#pragma unroll
                    for (int bj = 0; bj < 2; ++bj) {
                        float o[8];
#pragma unroll
                        for (int n = 0; n < 2; ++n)
#pragma unroll
                            for (int j = 0; j < 4; ++j) { const float v = acc[ai][bj][m][n][j] * s; o[n * 4 + j] = is_u ? v : fast_sigmoid(v); }
                        *(u32x4*)(dstb + (size_t)row * ld + ct * 256 + bj * 128 + wc * 32 + fq * 8) = pack8(o);
                    }
                }
        }
    }
};
struct EpiGlu {
    static constexpr bool PERM = true;
    const bf16_t* Z; const float* bias; bf16_t* O;
    __device__ __forceinline__ void operator()(const AccT& acc, const Unit& u, int wr, int wc, int fr, int fq) const {
#pragma unroll
        for (int ai = 0; ai < 2; ++ai)
#pragma unroll
            for (int m = 0; m < 4; ++m) {
                const int row = u.pm * 256 + ai * 128 + wr * 64 + m * 16 + fr;
#pragma unroll
                for (int bj = 0; bj < 2; ++bj) {
                    const int c0 = u.pn * 256 + bj * 128 + wc * 32 + fq * 8;
                    float z[8], o[8]; unpack8(*(const u32x4*)(Z + (size_t)row * 512 + c0), z);
                    const f32x4 b0 = *(const f32x4*)(bias + c0), b1 = *(const f32x4*)(bias + c0 + 4);
#pragma unroll
                    for (int j = 0; j < 4; ++j) { o[j] = z[j] * fast_sigmoid(acc[ai][bj][m][0][j] + b0[j]); o[4 + j] = z[4 + j] * fast_sigmoid(acc[ai][bj][m][1][j] + b1[j]); }
                    *(u32x4*)(O + (size_t)row * 512 + c0) = pack8(o);
                }
            }
    }
};
template <bool ADD> struct EpiGate {
    static constexpr bool PERM = true;
    const bf16_t* G; bf16_t* O;
    __device__ __forceinline__ void operator()(const AccT& acc, const Unit& u, int wr, int wc, int fr, int fq) const {
#pragma unroll
        for (int ai = 0; ai < 2; ++ai)
#pragma unroll
            for (int m = 0; m < 4; ++m) {
                const int row = u.pm * 256 + ai * 128 + wr * 64 + m * 16 + fr;
#pragma unroll
                for (int bj = 0; bj < 2; ++bj) {
                    const size_t off = (size_t)row * 1024 + u.pn * 256 + bj * 128 + wc * 32 + fq * 8;
                    float gt[8], o[8]; unpack8(*(const u32x4*)(G + off), gt);
                    if (ADD) unpack8(*(const u32x4*)(O + off), o); else {
#pragma unroll
                        for (int j = 0; j < 8; ++j) o[j] = 0.f; }
#pragma unroll
                    for (int j = 0; j < 4; ++j) { o[j] += gt[j] * acc[ai][bj][m][0][j]; o[4 + j] += gt[4 + j] * acc[ai][bj][m][1][j]; }
                    *(u32x4*)(O + off) = pack8(o);
                }
            }
    }
    __device__ __forceinline__ void tail(f32x4 v, int row, int col, int lane) const {
        const size_t off = (size_t)row * 1024 + col;
        const u32x2 gw = *(const u32x2*)(G + off);
        f32x4 o = (f32x4){0.f, 0.f, 0.f, 0.f};
        if (ADD) { const u32x2 pw = *(const u32x2*)(O + off); o = (f32x4){bf_lo(pw.x), bf_hi(pw.x), bf_lo(pw.y), bf_hi(pw.y)}; }
        o[0] += bf_lo(gw.x) * v[0]; o[1] += bf_hi(gw.x) * v[1]; o[2] += bf_lo(gw.y) * v[2]; o[3] += bf_hi(gw.y) * v[3];
        u32x2 w; w.x = cvt_pk(o[0], o[1]); w.y = cvt_pk(o[2], o[3]); *(u32x2*)(O + off) = w;
    }
};

template <class TEpi>
__device__ __forceinline__ void tail_gemm(LAS unsigned char* lds, const bf16_t* A, int lda, const bf16_t* Bt, int ldb, int K, int tile, const TEpi& E, int tid, int lane, int wave) {
    const int tm = tile >> 4, tn = tile & 15, c = lane & 15, q4 = lane >> 4;
    const int kw = K >> 3, nsteps = kw >> 5;
    f32x4 acc[2][4];
#pragma unroll
    for (int mt = 0; mt < 2; ++mt)
#pragma unroll
        for (int nt = 0; nt < 4; ++nt) acc[mt][nt] = (f32x4){0.f, 0.f, 0.f, 0.f};
    const bf16_t* ap = A + (size_t)(tm * 32 + c) * lda + wave * kw + 8 * q4;
    const bf16_t* bp = Bt + (size_t)(tn * 64 + c) * ldb + wave * kw + 8 * q4;
#pragma unroll 1
    for (int s0 = 0; s0 < nsteps; s0 += 6) {
        const int cnt = nsteps - s0;
        bf16x8 af[6][2], bf[6][4];
#pragma unroll
        for (int j = 0; j < 6; ++j) if (j < cnt) {
#pragma unroll
            for (int mt = 0; mt < 2; ++mt) af[j][mt] = *(const bf16x8*)(ap + (size_t)mt * 16 * lda + (s0 + j) * 32);
#pragma unroll
            for (int nt = 0; nt < 4; ++nt) bf[j][nt] = *(const bf16x8*)(bp + (size_t)nt * 16 * ldb + (s0 + j) * 32);
        }
#pragma unroll
        for (int j = 0; j < 6; ++j) if (j < cnt) {
#pragma unroll
            for (int mt = 0; mt < 2; ++mt)
#pragma unroll
                for (int nt = 0; nt < 4; ++nt) acc[mt][nt] = __builtin_amdgcn_mfma_f32_16x16x32_bf16(af[j][mt], bf[j][nt], acc[mt][nt], 0, 0, 0);
        }
    }
    asm volatile("s_nop 15" : "+v"(acc[0][0]), "+v"(acc[0][1]), "+v"(acc[0][2]), "+v"(acc[0][3]), "+v"(acc[1][0]), "+v"(acc[1][1]), "+v"(acc[1][2]), "+v"(acc[1][3]));
    LAS float* part = (LAS float*)lds + wave * 2048;
#pragma unroll
    for (int mt = 0; mt < 2; ++mt)
#pragma unroll
        for (int nt = 0; nt < 4; ++nt)
#pragma unroll
            for (int i = 0; i < 4; ++i) part[(16 * mt + 4 * q4 + i) * 64 + 16 * nt + c] = acc[mt][nt][i];
    __syncthreads();
    const int row = tid >> 4, cg4 = (tid & 15) * 4;
    f32x4 sum = (f32x4){0.f, 0.f, 0.f, 0.f};
#pragma unroll
    for (int w = 0; w < 8; ++w) sum += *(const LAS f32x4*)((LAS float*)lds + w * 2048 + row * 64 + cg4);
    E.tail(sum, MP + tm * 32 + row, tn * 64 + cg4, lane);
    __syncthreads();
}

struct Args { const float* in[32]; float* out; unsigned char* ws; int ph_lo, ph_hi; };
enum { I_XP = 0, I_XS, I_CK, I_CV, I_SRE, I_SIM, I_F1N, I_F1W1, I_F1W3, I_F1W2, I_MIXN, I_WIN, I_QN, I_KN, I_SINK, I_WAO, I_ARE, I_AIM, I_LDT, I_BRE, I_BIM,
       I_CRE, I_CIM, I_DSK, I_WGLU, I_BGLU, I_WSO, I_WOUT, I_F2N, I_F2W1, I_F2W3, I_F2W2 };

__device__ __forceinline__ void transpose_item(const float* W, int ldw, int cola, int colb, const float* gain, bf16_t* WT, int ldt, int drow0, int k0, LAS float* scr, int lane) {
    const int n4 = (lane & 15) * 4, scol = (n4 < 32 ? cola + n4 : colb + n4 - 32);
    f32x4 v[16];
#pragma unroll
    for (int i = 0; i < 16; ++i) { const int kk = 4 * i + (lane >> 4); v[i] = __builtin_nontemporal_load((const f32x4*)(W + (size_t)(k0 + kk) * ldw + scol)); }
#pragma unroll
    for (int i = 0; i < 16; ++i) { const int kk = 4 * i + (lane >> 4); const float gk = gain ? gain[k0 + kk] : 1.f; LAS float* d = scr + kk * 65 + n4;
        d[0] = v[i][0] * gk; d[1] = v[i][1] * gk; d[2] = v[i][2] * gk; d[3] = v[i][3] * gk; }
    asm volatile("s_waitcnt lgkmcnt(0)" ::: "memory");
    const int c = lane & 7;
#pragma unroll
    for (int j = 0; j < 8; ++j) { const int n = (lane >> 3) + 8 * j; const LAS float* sp = scr + (8 * c) * 65 + n;
        u32x4 o; o.x = cvt_pk(sp[0 * 65], sp[1 * 65]); o.y = cvt_pk(sp[2 * 65], sp[3 * 65]); o.z = cvt_pk(sp[4 * 65], sp[5 * 65]); o.w = cvt_pk(sp[6 * 65], sp[7 * 65]);
        *(u32x4*)(WT + (size_t)(drow0 + n) * ldt + k0 + 8 * c) = o; }
    asm volatile("s_waitcnt lgkmcnt(0)" ::: "memory");
}

__device__ __forceinline__ void prologue(const Args& a, LAS unsigned char* lds, int tid, int lane, int wave, int G) {
    unsigned char* ws = a.ws;
    LAS float* scr = (LAS float*)(lds + wave * 16640);
    const int gw = blockIdx.x * 8 + wave, NGW = G * 8;
    constexpr int I13 = 88 * 16, I2 = 16 * 44, IIN = 52 * 16, IGLU = 8 * 8, IAO = 16 * 8, IOUT = 16 * 16;
    constexpr int NIT = 2 * I13 + 2 * I2 + IIN + IGLU + 2 * IAO + IOUT;
    for (int it = gw; it < NIT; it += NGW) {
        int r = it;
        if (r < 2 * I13) {
            const int which = r / I13; r -= which * I13; const int nb = r / 16, kb = r % 16, p = nb >> 2, h = (nb >> 1) & 1, j0 = (nb & 1) * 64;
            const float* W = which ? (h ? a.in[I_F2W3] : a.in[I_F2W1]) : (h ? a.in[I_F1W3] : a.in[I_F1W1]);
            transpose_item(W, FF, 128 * p + j0, 128 * p + j0 + 32, which ? a.in[I_F2N] : a.in[I_F1N], (bf16_t*)(ws + (which ? WS_W13B : WS_W13A)), 1024, nb * 64, kb * 64, scr, lane); continue; }
        r -= 2 * I13;
        if (r < 2 * I2) { const int which = r / I2; r -= which * I2; const int nb = r / 44, kb = r % 44;
            transpose_item(which ? a.in[I_F2W2] : a.in[I_F1W2], D, nb * 64, nb * 64 + 32, nullptr, (bf16_t*)(ws + (which ? WS_W2B : WS_W2A)), FF, nb * 64, kb * 64, scr, lane); continue; }
        r -= 2 * I2;
        if (r < IIN) { const int nb = r / 16, kb = r % 16, pn = nb >> 2, cb = (nb & 3) * 2;
            const int cola = pn <= 2 ? 256 * pn + 64 * (cb & 3) + 32 * (cb >> 2) : nb * 64, colb = pn <= 2 ? 256 * pn + 64 * ((cb + 1) & 3) + 32 * ((cb + 1) >> 2) : nb * 64 + 32;
            transpose_item(a.in[I_WIN], NIN, cola, colb, a.in[I_MIXN], (bf16_t*)(ws + WS_WIN), 1024, nb * 64, kb * 64, scr, lane); continue; }
        r -= IIN;
        if (r < IGLU) { const int nb = r / 8, kb = r % 8; transpose_item(a.in[I_WGLU], 512, nb * 64, nb * 64 + 32, nullptr, (bf16_t*)(ws + WS_WGLU), 512, nb * 64, kb * 64, scr, lane); continue; }
        r -= IGLU;
        if (r < 2 * IAO) { const int which = r / IAO; r -= which * IAO; const int nb = r / 8, kb = r % 8;
            transpose_item(which ? a.in[I_WSO] : a.in[I_WAO], D, nb * 64, nb * 64 + 32, nullptr, (bf16_t*)(ws + (which ? WS_WSO : WS_WAO)), 512, nb * 64, kb * 64, scr, lane); continue; }
        r -= 2 * IAO;
        { const int nb = r / 16, kb = r % 16; transpose_item(a.in[I_WOUT], D, nb * 64, nb * 64 + 32, nullptr, (bf16_t*)(ws + WS_WOUT), 1024, nb * 64, kb * 64, scr, lane); }
    }
    float* rs0 = (float*)(ws + WS_RS0); bf16_t* XB = (bf16_t*)(ws + WS_XB);
    for (int grp = blockIdx.x; grp < M / 32; grp += G)
#pragma unroll 1
      for (int j4 = 0; j4 < 4; ++j4) {
        const int m = grp * 32 + wave * 4 + j4;
        const float* xr = m < MP ? a.in[I_XP] + (size_t)m * D : a.in[I_XS] + (size_t)(m - MP) * D;
        f32x4 v[4]; float s = 0.f;
#pragma unroll
        for (int j = 0; j < 4; ++j) { v[j] = __builtin_nontemporal_load((const f32x4*)xr + lane + 64 * j); s += (v[j][0] * v[j][0] + v[j][1] * v[j][1]) + (v[j][2] * v[j][2] + v[j][3] * v[j][3]); }
        s = wave_sum(s);
        if (lane == 0) rs0[m] = rsqrtf(s * (1.f / 1024.f) + EPS);
#pragma unroll
        for (int j = 0; j < 4; ++j) { u32x2 w; w.x = cvt_pk(v[j][0], v[j][1]); w.y = cvt_pk(v[j][2], v[j][3]); ((u32x2*)(XB + (size_t)m * D))[lane + 64 * j] = w; }
      }
    const int gt = blockIdx.x * 512 + tid, NGT = G * 512;
    { float* ss1 = (float*)(ws + WS_SS1); float* ss2 = (float*)(ws + WS_SS2); for (int i = gt; i < M; i += NGT) { ss1[i] = 0.f; ss2[i] = 0.f; } }
    if (gt < 2048) {
        const int g = gt >> 6, n = gt & 63;
        const float dt = expf(a.in[I_LDT][g]), are = a.in[I_ARE][gt], aim = a.in[I_AIM][gt];
        const float mag = expf(dt * are), abr = mag * cosf(dt * aim), abi = mag * sinf(dt * aim);
        const float den = are * are + aim * aim, nr = abr - 1.f, ni = abi;
        const float fre = (nr * are + ni * aim) / den, fim = (ni * are - nr * aim) / den;
        float* AB = (float*)(ws + WS_AB); bf16_t* BBT = (bf16_t*)(ws + WS_BBT); bf16_t* CMT = (bf16_t*)(ws + WS_CMT);
        float pr = abr, pi = abi;
#pragma unroll
        for (int i = 0; i < 8; ++i) { const float t = pr * pr - pi * pi; pi = 2.f * pr * pi; pr = t; }
        AB[gt] = abr; AB[2048 + gt] = abi; AB[4096 + gt] = pr; AB[6144 + gt] = pi;
        for (int c = 0; c < 16; ++c) {
            const float br = a.in[I_BRE][gt * 16 + c], bi = a.in[I_BIM][gt * 16 + c];
            { const float vr = fre * br - fim * bi, vi = fre * bi + fim * br;
              const unsigned hr = cvt_pk(vr, 0.f) & 0xffffu, hi_ = cvt_pk(vi, 0.f) & 0xffffu;
              const unsigned lr = cvt_pk(vr - __uint_as_float(hr << 16), 0.f) & 0xffffu, li = cvt_pk(vi - __uint_as_float(hi_ << 16), 0.f) & 0xffffu;
              bf16_t* t0 = BBT + (size_t)(g * 128 + 2 * n) * 32 + c; t0[0] = (bf16_t)hr; t0[16] = (bf16_t)lr; t0[32] = (bf16_t)hi_; t0[48] = (bf16_t)li; }
            const float cr = a.in[I_CRE][(g * 16 + c) * 64 + n], ci = a.in[I_CIM][(g * 16 + c) * 64 + n];
            *(unsigned*)(CMT + (size_t)(g * 16 + c) * 128 + 2 * n) = cvt_pk(cr, -ci);
        }
    }
}

constexpr int KP = 144, VP = 520;
constexpr int AT_K = 0, AT_V = 256 * KP;
__device__ __forceinline__ void attn_wave_task(const LAS unsigned char* lds, int kbase, const bf16_t* qptr, int rl, int kmin, float sink, bf16_t* optr, bool store, int lane) {
    const int r = lane & 31, h = lane >> 5;
    bf16x8 qf[4];
#pragma unroll
    for (int s = 0; s < 4; ++s) qf[s] = *(const bf16x8*)(qptr + 16 * s + 8 * h);
    f32x16 S[5];
#pragma unroll
    for (int kt = 0; kt < 5; ++kt) {
#pragma unroll
        for (int i = 0; i < 16; ++i) S[kt][i] = 0.f;
#pragma unroll
        for (int s = 0; s < 4; ++s) {
            const bf16x8 kf = *(const LAS bf16x8*)(lds + AT_K + (kbase + 32 * kt + r) * KP + 32 * s + 16 * h);
            S[kt] = __builtin_amdgcn_mfma_f32_32x32x16_bf16(kf, qf[s], S[kt], 0, 0, 0);
        }
    }
    float mx = sink;
#pragma unroll
    for (int kt = 0; kt < 5; ++kt)
#pragma unroll
        for (int i = 0; i < 16; ++i) {
            const int kk = 32 * kt + (i & 3) + 8 * (i >> 2) + 4 * h;
            const bool ok = (kk > rl) && (kk <= 128 + rl) && (kk >= kmin);
            const float v = ok ? S[kt][i] : -1e30f; S[kt][i] = v; mx = fmaxf(mx, v);
        }
    mx = fmaxf(mx, __shfl_xor(mx, 32));
    float sum = 0.f;
#pragma unroll
    for (int kt = 0; kt < 5; ++kt)
#pragma unroll
        for (int i = 0; i < 16; ++i) { const float p = __builtin_amdgcn_exp2f(S[kt][i] - mx); S[kt][i] = p; sum += p; }
    sum += __shfl_xor(sum, 32);
    const float rden = 1.f / (sum + __builtin_amdgcn_exp2f(sink - mx));
    f32x16 O[2];
#pragma unroll
    for (int dt = 0; dt < 2; ++dt)
#pragma unroll
        for (int i = 0; i < 16; ++i) O[dt][i] = 0.f;
#pragma unroll
    for (int kt = 0; kt < 5; ++kt)
#pragma unroll
        for (int s2 = 0; s2 < 2; ++s2) {
            u32x4 pw; pw.x = cvt_pk(S[kt][8 * s2 + 0], S[kt][8 * s2 + 1]); pw.y = cvt_pk(S[kt][8 * s2 + 2], S[kt][8 * s2 + 3]);
            pw.z = cvt_pk(S[kt][8 * s2 + 4], S[kt][8 * s2 + 5]); pw.w = cvt_pk(S[kt][8 * s2 + 6], S[kt][8 * s2 + 7]);
            const bf16x8 pf = __builtin_bit_cast(bf16x8, pw);
#pragma unroll
            for (int dt = 0; dt < 2; ++dt) {
                const LAS unsigned char* vp = lds + AT_V + (32 * dt + r) * VP + (kbase + 32 * kt + 16 * s2 + 4 * h) * 2;
                const u32x2 v0 = *(const LAS u32x2*)vp, v1 = *(const LAS u32x2*)(vp + 16);
                u32x4 vw; vw.x = v0.x; vw.y = v0.y; vw.z = v1.x; vw.w = v1.y;
                O[dt] = __builtin_amdgcn_mfma_f32_32x32x16_bf16(__builtin_bit_cast(bf16x8, vw), pf, O[dt], 0, 0, 0);
            }
        }
    if (store) {
#pragma unroll
        for (int dt = 0; dt < 2; ++dt)
#pragma unroll
            for (int g4 = 0; g4 < 4; ++g4) {
                u32x2 w; w.x = cvt_pk(O[dt][4 * g4 + 0] * rden, O[dt][4 * g4 + 1] * rden); w.y = cvt_pk(O[dt][4 * g4 + 2] * rden, O[dt][4 * g4 + 3] * rden);
                *(u32x2*)(optr + 32 * dt + 8 * g4 + 4 * h) = w;
            }
    }
}

__device__ __forceinline__ void attn_unit(const Args& a, LAS unsigned char* lds, int unit, int tid, int lane, int wave) {
    unsigned char* ws = a.ws;
    const bf16_t* Qb = (const bf16_t*)(ws + WS_Q); const bf16_t* Kb = (const bf16_t*)(ws + WS_K); const bf16_t* Vb = (const bf16_t*)(ws + WS_V); bf16_t* AO = (bf16_t*)(ws + WS_ATTN);
    const float* sinks = a.in[I_SINK];
    if (unit < 256) {
        const int b = unit >> 7, kvh = (unit >> 6) & 1, qb = unit & 63;
#pragma unroll
        for (int i = 0; i < 4; ++i) {
            const int q = tid + 512 * i, c = q >> 3, dch = q & 7, t = (qb - 1) * 128 + c;
            u32x4 kv = (u32x4){0u, 0u, 0u, 0u}, vv = kv;
            if (t >= 0) { const size_t off = (size_t)(b * SEQ + t) * 128 + kvh * 64 + dch * 8; kv = *(const u32x4*)(Kb + off); vv = *(const u32x4*)(Vb + off); }
            *(LAS u32x4*)(lds + AT_K + c * KP + dch * 16) = kv;
            LAS bf16_t* vt = (LAS bf16_t*)(lds + AT_V + (dch * 8) * VP + c * 2);
            vt[0 * (VP / 2)] = (bf16_t)(vv.x & 0xffff); vt[1 * (VP / 2)] = (bf16_t)(vv.x >> 16); vt[2 * (VP / 2)] = (bf16_t)(vv.y & 0xffff); vt[3 * (VP / 2)] = (bf16_t)(vv.y >> 16);
            vt[4 * (VP / 2)] = (bf16_t)(vv.z & 0xffff); vt[5 * (VP / 2)] = (bf16_t)(vv.z >> 16); vt[6 * (VP / 2)] = (bf16_t)(vv.w & 0xffff); vt[7 * (VP / 2)] = (bf16_t)(vv.w >> 16);
        }
        __syncthreads();
#pragma unroll 1
        for (int task = wave; task < 16; task += 8) {
            const int hq = task >> 2, r0 = 32 * (task & 3), r = lane & 31;
            const size_t row = (size_t)b * SEQ + qb * 128 + r0 + r; const int head = kvh * 4 + hq;
            attn_wave_task(lds, r0, Qb + row * 512 + head * 64, r, qb == 0 ? 128 - r0 : 0, sinks[head] * LOG2E, AO + row * 512 + head * 64, true, lane);
        }
        __syncthreads();
    } else {
        const int su = unit - 256, b = su >> 1, kvh = su & 1;
        for (int q = tid; q < 160 * 8; q += 512) {
            const int c = q >> 3, dch = q & 7;
            u32x4 kv = (u32x4){0u, 0u, 0u, 0u}, vv = kv;
            if (c < 128) {
                const size_t off = ((size_t)(b * 128 + c) * 2 + kvh) * 64 + dch * 8;
                const f32x4 k0 = __builtin_nontemporal_load((const f32x4*)(a.in[I_CK] + off)), k1 = __builtin_nontemporal_load((const f32x4*)(a.in[I_CK] + off + 4)), v0 = __builtin_nontemporal_load((const f32x4*)(a.in[I_CV] + off)), v1 = __builtin_nontemporal_load((const f32x4*)(a.in[I_CV] + off + 4));
                kv.x = cvt_pk(k0[0], k0[1]); kv.y = cvt_pk(k0[2], k0[3]); kv.z = cvt_pk(k1[0], k1[1]); kv.w = cvt_pk(k1[2], k1[3]);
                vv.x = cvt_pk(v0[0], v0[1]); vv.y = cvt_pk(v0[2], v0[3]); vv.z = cvt_pk(v1[0], v1[1]); vv.w = cvt_pk(v1[2], v1[3]);
            } else if (c < 132) { const size_t off = (size_t)(MP + 4 * b + (c - 128)) * 128 + kvh * 64 + dch * 8; kv = *(const u32x4*)(Kb + off); vv = *(const u32x4*)(Vb + off); }
            *(LAS u32x4*)(lds + AT_K + c * KP + dch * 16) = kv;
            LAS bf16_t* vt = (LAS bf16_t*)(lds + AT_V + (dch * 8) * VP + c * 2);
            vt[0 * (VP / 2)] = (bf16_t)(vv.x & 0xffff); vt[1 * (VP / 2)] = (bf16_t)(vv.x >> 16); vt[2 * (VP / 2)] = (bf16_t)(vv.y & 0xffff); vt[3 * (VP / 2)] = (bf16_t)(vv.y >> 16);
            vt[4 * (VP / 2)] = (bf16_t)(vv.z & 0xffff); vt[5 * (VP / 2)] = (bf16_t)(vv.z >> 16); vt[6 * (VP / 2)] = (bf16_t)(vv.w & 0xffff); vt[7 * (VP / 2)] = (bf16_t)(vv.w >> 16);
        }
        __syncthreads();
        if (wave == 0) {
            const int i = lane & 15, hq = i >> 2, t = i & 3, head = kvh * 4 + hq;
            const size_t row = (size_t)MP + 4 * b + t;
            attn_wave_task(lds, 0, Qb + row * 512 + head * 64, t, 0, sinks[head] * LOG2E, AO + row * 512 + head * 64, (lane & 31) < 16, lane);
        }
        __syncthreads();
    }
}

constexpr int BUP = 528, XP = 272, SSM_WLDS = 16 * BUP + 16 * XP;
template <int PASS>
__device__ __forceinline__ void ssm_item(const Args& a, LAS unsigned char* wl, int b, int g, int seg, bool sample, int lane) {
    unsigned char* ws = a.ws;
    const bf16_t* U = (const bf16_t*)(ws + WS_U); const float* AB = (const float*)(ws + WS_AB); const bf16_t* BBT = (const bf16_t*)(ws + WS_BBT);
    f32x2* E = (f32x2*)(ws + WS_E);
    LAS unsigned char* bu = wl; LAS unsigned char* xl = wl + 16 * BUP;
    int row0, nblk, tcount;
    if (sample) { row0 = MP + 4 * b; nblk = 1; tcount = 4; }
    else { row0 = b * SEQ + seg * 256; nblk = 16; tcount = 16; }
    const int n = lane, gn = g * 64 + n, c = lane & 15, q4 = lane >> 4;
    const bf16x8 zero8 = (bf16x8){0, 0, 0, 0, 0, 0, 0, 0};
    bf16x8 bb[8];
#pragma unroll
    for (int vt = 0; vt < 8; ++vt) bb[vt] = *(const bf16x8*)(BBT + (size_t)((g * 128 + 16 * vt + c) * 32 + 8 * q4));
    const float abr = AB[gn], abi = AB[2048 + gn];
    float xr = 0.f, xi = 0.f;
    if (PASS == 2) {
        if (sample) { xr = a.in[I_SRE][(size_t)(b * 32 + g) * 64 + n]; xi = a.in[I_SIM][(size_t)(b * 32 + g) * 64 + n]; }
        else {
            const float alr = AB[4096 + gn], ali = AB[6144 + gn];
            const f32x2* Ep = E + (size_t)((b * 32 + g) * 32) * 64 + n;
#pragma unroll 8
            for (int j = 0; j < seg; ++j) { const f32x2 e = Ep[(size_t)j * 64]; const float t = fmaf(alr, xr, fmaf(-ali, xi, e.x)); xi = fmaf(alr, xi, fmaf(ali, xr, e.y)); xr = t; }
        }
    }
    bf16x8 cm[4]; float dsk = 0.f;
    if (PASS == 2) {
        const bf16_t* CMT = (const bf16_t*)(ws + WS_CMT);
#pragma unroll
        for (int ks = 0; ks < 4; ++ks) cm[ks] = *(const bf16x8*)(CMT + (size_t)(g * 16 + c) * 128 + ks * 32 + q4 * 8);
        dsk = a.in[I_DSK][g * 16 + c];
    }
    const int tclamp = c < tcount ? c : tcount - 1;
    bf16x8 ucur = *(const bf16x8*)(U + (size_t)(row0 + tclamp) * 512 + g * 16 + 8 * (q4 & 1));
    bf16_t uscur[4];
    if (PASS == 2) {
#pragma unroll
        for (int i = 0; i < 4; ++i) { const int tok = 4 * q4 + i; uscur[i] = U[(size_t)(row0 + (tok < tcount ? tok : tcount - 1)) * 512 + g * 16 + c]; }
    }
#pragma unroll 1
    for (int blk = 0; blk < nblk; ++blk) {
        const int r0 = row0 + blk * 16;
        bf16x8 unext = zero8; bf16_t usnext[4] = {0, 0, 0, 0};
        if (blk + 1 < nblk) {
            unext = *(const bf16x8*)(U + (size_t)(r0 + 16 + c) * 512 + g * 16 + 8 * (q4 & 1));
            if (PASS == 2) {
#pragma unroll
                for (int i = 0; i < 4; ++i) usnext[i] = U[(size_t)(r0 + 16 + 4 * q4 + i) * 512 + g * 16 + c];
            }
        }
        f32x4 d[8];
#pragma unroll
        for (int vt = 0; vt < 8; ++vt) d[vt] = __builtin_amdgcn_mfma_f32_16x16x32_bf16(ucur, bb[vt], (f32x4){0.f, 0.f, 0.f, 0.f}, 0, 0, 0);
        asm volatile("s_nop 15" : "+v"(d[0]), "+v"(d[1]), "+v"(d[2]), "+v"(d[3]), "+v"(d[4]), "+v"(d[5]), "+v"(d[6]), "+v"(d[7]));
#pragma unroll
        for (int vt = 0; vt < 8; ++vt)
#pragma unroll
            for (int i = 0; i < 4; ++i) *(LAS float*)(bu + (4 * q4 + i) * BUP + (16 * vt + c) * 4) = d[vt][i];
        asm volatile("" :: "v"(ucur));
        asm volatile("s_waitcnt lgkmcnt(0)" ::: "memory");
#pragma unroll
        for (int tt = 0; tt < 16; ++tt) {
            if (tt < tcount) {
                const f32x2 v = *(const LAS f32x2*)(bu + tt * BUP + n * 8);
                const float nxr = fmaf(abr, xr, fmaf(-abi, xi, v.x)), nxi = fmaf(abr, xi, fmaf(abi, xr, v.y));
                xr = nxr; xi = nxi;
                if (PASS == 2) *(LAS unsigned*)(xl + tt * XP + n * 4) = cvt_pk(xr, xi);
            }
        }
        asm volatile("s_waitcnt lgkmcnt(0)" ::: "memory");
        if (PASS == 2) {
            bf16_t* Z = (bf16_t*)(ws + WS_Z);
            f32x4 acc = (f32x4){0.f, 0.f, 0.f, 0.f};
#pragma unroll
            for (int ks = 0; ks < 4; ++ks) {
                const bf16x8 af = *(const LAS bf16x8*)(xl + c * XP + ks * 64 + q4 * 16);
                acc = __builtin_amdgcn_mfma_f32_16x16x32_bf16(af, cm[ks], acc, 0, 0, 0);
            }
#pragma unroll
            for (int i = 0; i < 4; ++i) {
                const int tok = 4 * q4 + i;
                if (tok < tcount) {
                    const float y = acc[i] + dsk * bf2f(uscur[i]);
                    const float z = y * fast_sigmoid(1.5957691216057308f * (y + 0.044715f * y * y * y));
                    Z[(size_t)(r0 + tok) * 512 + g * 16 + c] = (bf16_t)(cvt_pk(z, 0.f) & 0xffff);
                }
            }
        }
        asm volatile("s_waitcnt lgkmcnt(0)" ::: "memory");
        ucur = unext;
#pragma unroll
        for (int i = 0; i < 4; ++i) uscur[i] = usnext[i];
    }
    if (PASS == 1) {
        const unsigned long long bits = ((unsigned long long)__float_as_uint(xi) << 32) | (unsigned long long)__float_as_uint(xr);
        __hip_atomic_store((unsigned long long*)(E + (size_t)((b * 32 + g) * 32 + seg) * 64 + n), bits, __ATOMIC_RELAXED, __HIP_MEMORY_SCOPE_AGENT);
    }
    else if (sample) { a.out[O_RES + (size_t)(b * 32 + g) * 64 + n] = xr; a.out[O_IMS + (size_t)(b * 32 + g) * 64 + n] = xi; }
    else if (seg == 31) { a.out[O_REP + (size_t)(b * 32 + g) * 64 + n] = xr; a.out[O_IMP + (size_t)(b * 32 + g) * 64 + n] = xi; }
}

constexpr size_t WS_BAR = 896 * KiB, BAR_BYTES = 16 * KiB;
#define XB_TMO      128
#define XB_XCNT(j)  (256  + 64 * (j))
#define XB_XSUB(j)  (1280 + 64 * (j))
#define XB_XGEN(j)  (2304 + 64 * (j))
#define XB_TOP      3328
#define XB_TOPGEN   3392
#define XB_SPIN_CAP (1u << 18)
__device__ __forceinline__ unsigned xb_ld(unsigned* p)              { return __hip_atomic_load(p, __ATOMIC_RELAXED, __HIP_MEMORY_SCOPE_AGENT); }
__device__ __forceinline__ unsigned xb_add(unsigned* p, unsigned v) { return __hip_atomic_fetch_add(p, v, __ATOMIC_RELAXED, __HIP_MEMORY_SCOPE_AGENT); }
__device__ __forceinline__ unsigned xb_xcc_id() { return (unsigned)__builtin_amdgcn_s_getreg((3 << 11) | 20) & 0xFu; }
#define XB_SPIN(cond, bar) do { unsigned _sp = 0; while (cond) { __builtin_amdgcn_s_sleep(1); \
    if ((++_sp & 255u) == 0u) { if (xb_ld(&(bar)[XB_TMO])) break; if (_sp > XB_SPIN_CAP) { atomicAdd(&(bar)[XB_TMO], 1u); break; } } } } while (0)
struct XcdBarrier { unsigned* bar; unsigned x; volatile LAS unsigned* st; };
__device__ __forceinline__ XcdBarrier xcd_barrier_post(unsigned* bar, volatile LAS unsigned* st) {
    XcdBarrier b; b.bar = bar; b.x = xb_xcc_id(); b.st = st;
    if (threadIdx.x == 0) (void)xb_add(&bar[XB_XCNT(b.x)], 1u);
    return b;
}
__device__ __forceinline__ void xcd_barrier_complete(unsigned* bar, unsigned x, unsigned& nloc, unsigned& nx) {
    const unsigned G = gridDim.x * gridDim.y * gridDim.z;
    unsigned sum, cnt, mine, sp = 0u;
    for (;;) {
        sum = 0u; cnt = 0u; mine = 0u;
#pragma unroll
        for (unsigned j = 0; j < 16; ++j) { const unsigned c = xb_ld(&bar[XB_XCNT(j)]); sum += c; cnt += (c > 0u) ? 1u : 0u; mine = (j == x) ? c : mine; }
        if (sum == G) break;
        __builtin_amdgcn_s_sleep(1);
        if ((++sp & 255u) == 0u) { if (xb_ld(&bar[XB_TMO])) break; if (sp > XB_SPIN_CAP) { atomicAdd(&bar[XB_TMO], 1u); break; } }
    }
    nloc = mine > 0u ? mine : 1u; nx = cnt > 0u ? cnt : 1u;
}
__device__ __forceinline__ void xcd_barrier(const XcdBarrier& b) {
    asm volatile("s_waitcnt vmcnt(0)" ::: "memory");
    __syncthreads();
    if (threadIdx.x == 0) {
        unsigned* bar = b.bar;
        __builtin_amdgcn_s_waitcnt(0);
        unsigned nloc = b.st[0], nx = b.st[1];
        if (nloc == 0u) { xcd_barrier_complete(bar, b.x, nloc, nx); b.st[0] = nloc; b.st[1] = nx; }
        const unsigned old = xb_add(&bar[XB_XSUB(b.x)], 1u);
        const unsigned gen = old / nloc;
        if (old + 1u == (gen + 1u) * nloc) {
            __builtin_amdgcn_fence(__ATOMIC_RELEASE, "agent");
            asm volatile("s_waitcnt vmcnt(0)" ::: "memory");
            const unsigned og = xb_add(&bar[XB_TOP], 1u);
            const unsigned tg = og / nx;
            if (og + 1u == (tg + 1u) * nx) xb_add(&bar[XB_TOPGEN], 1u);
            else XB_SPIN(xb_ld(&bar[XB_TOPGEN]) == tg, bar);
            __builtin_amdgcn_fence(__ATOMIC_ACQUIRE, "agent");
            xb_add(&bar[XB_XGEN(b.x)], 1u);
            asm volatile("s_waitcnt vmcnt(0)" ::: "memory");
        } else {
            XB_SPIN(xb_ld(&bar[XB_XGEN(b.x)]) == gen, bar);
            __builtin_amdgcn_fence(__ATOMIC_ACQUIRE, "agent");
            asm volatile("s_waitcnt vmcnt(0)" ::: "memory");
        }
    }
    __syncthreads();
}

__global__ void __launch_bounds__(512, 2) fwd_kernel(Args a) {
    extern __shared__ __attribute__((aligned(16))) unsigned char lds_raw[];
    LAS unsigned char* lds = (LAS unsigned char*)lds_raw;
    const int tid = threadIdx.x, lane = tid & 63, wave = __builtin_amdgcn_readfirstlane(tid >> 6), G = gridDim.x;
    unsigned char* ws = a.ws;
    const int lo = a.ph_lo, hi = a.ph_hi;
    cg::grid_group grid = cg::this_grid();
#ifndef PROBE_PHASE
#define PROBE_PHASE -1
#endif
#define IN(k) (lo <= (k) && (k) < hi)
#if PROBE_PHASE >= 0
#define PH_BEGIN(k) _Pragma("unroll 1") for (int _r = 0; _r < ((PROBE_PHASE) == (k) ? 2 : 1); ++_r) { if (IN(k)) {
#define PH_END(k) } SEAM(k); }
#else
#define PH_BEGIN(k) if (IN(k)) {
#define PH_END(k) } SEAM(k);
#endif
#define SEAM(k) do { if (IN(k) && IN((k) + 1)) { xcd_barrier(xbar); } } while (0)
    { volatile LAS unsigned* st = (volatile LAS unsigned*)(lds + LDS_BYTES - 64); if (tid == 0) { st[0] = 0u; st[1] = 0u; } __syncthreads(); }
    if (hi > 1000) grid.sync();
    const XcdBarrier xbar = xcd_barrier_post((unsigned*)(ws + WS_BAR), (volatile LAS unsigned*)(lds + LDS_BYTES - 64));
    bf16_t* XB = (bf16_t*)(ws + WS_XB); bf16_t* ACT = (bf16_t*)(ws + WS_ACT);
    float* Y = a.out + O_Y;

    PH_BEGIN(0) prologue(a, lds, tid, lane, wave, G); PH_END(0)
    PH_BEGIN(1)
        pg8::Gemm g{XB, (const bf16_t*)(ws + WS_W13A), M, 2 * FF, D, D, D}; pg8::StaticOrder S; S.init(M, 2 * FF, G, (int)blockIdx.x);
        EpiSwiglu E{ACT, (const float*)(ws + WS_RS0), 0};
        pg8::gemm_phase(lds, g, S, E);
    PH_END(1)
    PH_BEGIN(2)
        pg8::Gemm g{ACT, (const bf16_t*)(ws + WS_W2A), MP, D, FF, FF, FF}; pg8::StaticOrder S; S.init(MP, D, G, (int)blockIdx.x);
        EpiResid E{a.in[I_XP], a.in[I_XS], nullptr, nullptr, XB, (float*)(ws + WS_SS1), 0.5f};
        if (blockIdx.x & 1) for (int tile = blockIdx.x; tile < 256; tile += G) tail_gemm(lds, ACT + (size_t)MP * FF, FF, (const bf16_t*)(ws + WS_W2A), FF, FF, tile, E, tid, lane, wave);
        pg8::gemm_phase(lds, g, S, E);
        if (!(blockIdx.x & 1)) for (int tile = blockIdx.x; tile < 256; tile += G) tail_gemm(lds, ACT + (size_t)MP * FF, FF, (const bf16_t*)(ws + WS_W2A), FF, FF, tile, E, tid, lane, wave);
    PH_END(2)
    PH_BEGIN(3)
        pg8::Gemm g{XB, (const bf16_t*)(ws + WS_WIN), M, NIN, D, D, D}; pg8::StaticOrder S; S.init(M, NIN, G, (int)blockIdx.x);
        EpiProj E{(const float*)(ws + WS_SS1), ws, a.in[I_QN], a.in[I_KN], a.out};
        pg8::gemm_phase(lds, g, S, E);
    PH_END(3)
    PH_BEGIN(4)
        for (int unit = blockIdx.x; unit < 512; unit += G) attn_unit(a, lds, unit, tid, lane, wave);
        for (int bi = blockIdx.x; bi < 256; bi += G) ssm_item<1>(a, lds + wave * SSM_WLDS, bi >> 7, ((bi >> 5) & 3) * 8 + wave, bi & 31, false, lane);
        {
            const int gt = blockIdx.x * 512 + tid, NGT = G * 512;
            for (int i0 = gt; i0 < 2 * 128 * 3968; i0 += 4 * NGT) {
                f32x4 v[4];
#pragma unroll
                for (int j = 0; j < 4; ++j) { const int i = i0 + j * NGT; if (i < 2 * 128 * 3968) { const int which = i / (128 * 3968), r = i % (128 * 3968), b = r / 3968, o = r % 3968;
                    v[j] = __builtin_nontemporal_load((const f32x4*)(a.in[which ? I_CV : I_CK] + (size_t)b * 16384 + 512) + o); } }
#pragma unroll
                for (int j = 0; j < 4; ++j) { const int i = i0 + j * NGT; if (i < 2 * 128 * 3968) { const int which = i / (128 * 3968), r = i % (128 * 3968), b = r / 3968, o = r % 3968;
                    __builtin_nontemporal_store(v[j], (f32x4*)(a.out + (which ? O_VS : O_KS) + (size_t)b * 16384) + o); } }
            }
        }
        __syncthreads();
    PH_END(4)
    PH_BEGIN(5)
        LAS unsigned char* xl = lds + wave * SSM_WLDS;
        for (int bi = blockIdx.x; bi < 256 + 512; bi += G) {
            if (bi < 256) ssm_item<2>(a, xl, bi >> 7, ((bi >> 5) & 3) * 8 + wave, bi & 31, false, lane);
            else { const int si = bi - 256; ssm_item<2>(a, xl, si >> 2, (si & 3) * 8 + wave, 0, true, lane); }
        }
        __syncthreads();
    PH_END(5)
    PH_BEGIN(6)
        {
            pg8::Gemm g{(const bf16_t*)(ws + WS_Z), (const bf16_t*)(ws + WS_WGLU), M, 512, 512, 512, 512}; pg8::StaticOrder S; S.init(M, 512, G, (int)blockIdx.x);
            EpiGlu E{(const bf16_t*)(ws + WS_Z), a.in[I_BGLU], (bf16_t*)(ws + WS_SSMB)};
            pg8::gemm_phase(lds, g, S, E);
        }
        {
            pg8::Gemm g{(const bf16_t*)(ws + WS_ATTN), (const bf16_t*)(ws + WS_WAO), MP, D, 512, 512, 512}; pg8::StaticOrder S; S.init(MP, D, G, (int)((blockIdx.x + G - 132 % G) % G));
            EpiGate<false> E{(const bf16_t*)(ws + WS_GA), (bf16_t*)(ws + WS_MERGED)};
            if (blockIdx.x & 1) for (int tile = blockIdx.x; tile < 256; tile += G) tail_gemm(lds, (const bf16_t*)(ws + WS_ATTN) + (size_t)MP * 512, 512, (const bf16_t*)(ws + WS_WAO), 512, 512, tile, E, tid, lane, wave);
            pg8::gemm_phase(lds, g, S, E);
            if (!(blockIdx.x & 1)) for (int tile = blockIdx.x; tile < 256; tile += G) tail_gemm(lds, (const bf16_t*)(ws + WS_ATTN) + (size_t)MP * 512, 512, (const bf16_t*)(ws + WS_WAO), 512, 512, tile, E, tid, lane, wave);
        }
    PH_END(6)
    PH_BEGIN(7)
        pg8::Gemm g{(const bf16_t*)(ws + WS_SSMB), (const bf16_t*)(ws + WS_WSO), MP, D, 512, 512, 512}; pg8::StaticOrder S; S.init(MP, D, G, (int)blockIdx.x);
        EpiGate<true> E{(const bf16_t*)(ws + WS_GS), (bf16_t*)(ws + WS_MERGED)};
        if (blockIdx.x & 1) for (int tile = blockIdx.x; tile < 256; tile += G) tail_gemm(lds, (const bf16_t*)(ws + WS_SSMB) + (size_t)MP * 512, 512, (const bf16_t*)(ws + WS_WSO), 512, 512, tile, E, tid, lane, wave);
        pg8::gemm_phase(lds, g, S, E);
        if (!(blockIdx.x & 1)) for (int tile = blockIdx.x; tile < 256; tile += G) tail_gemm(lds, (const bf16_t*)(ws + WS_SSMB) + (size_t)MP * 512, 512, (const bf16_t*)(ws + WS_WSO), 512, 512, tile, E, tid, lane, wave);
    PH_END(7)
    PH_BEGIN(8)
        pg8::Gemm g{(const bf16_t*)(ws + WS_MERGED), (const bf16_t*)(ws + WS_WOUT), MP, D, D, D, D}; pg8::StaticOrder S; S.init(MP, D, G, (int)blockIdx.x);
        EpiResid E{nullptr, nullptr, XB, nullptr, XB, (float*)(ws + WS_SS2), 1.0f};
        if (blockIdx.x & 1) for (int tile = blockIdx.x; tile < 256; tile += G) tail_gemm(lds, (const bf16_t*)(ws + WS_MERGED) + (size_t)MP * D, D, (const bf16_t*)(ws + WS_WOUT), D, D, tile, E, tid, lane, wave);
        pg8::gemm_phase(lds, g, S, E);
        if (!(blockIdx.x & 1)) for (int tile = blockIdx.x; tile < 256; tile += G) tail_gemm(lds, (const bf16_t*)(ws + WS_MERGED) + (size_t)MP * D, D, (const bf16_t*)(ws + WS_WOUT), D, D, tile, E, tid, lane, wave);
    PH_END(8)
    PH_BEGIN(9)
        pg8::Gemm g{XB, (const bf16_t*)(ws + WS_W13B), M, 2 * FF, D, D, D}; pg8::StaticOrder S; S.init(M, 2 * FF, G, (int)blockIdx.x);
        EpiSwiglu E{ACT, (const float*)(ws + WS_SS2), 1};
        pg8::gemm_phase(lds, g, S, E);
    PH_END(9)
    if (IN(10)) {
        pg8::Gemm g{ACT, (const bf16_t*)(ws + WS_W2B), MP, D, FF, FF, FF}; pg8::StaticOrder S; S.init(MP, D, G, (int)blockIdx.x);
        EpiResid E{nullptr, nullptr, XB, Y, nullptr, nullptr, 0.5f};
        if (blockIdx.x & 1) for (int tile = blockIdx.x; tile < 256; tile += G) tail_gemm(lds, ACT + (size_t)MP * FF, FF, (const bf16_t*)(ws + WS_W2B), FF, FF, tile, E, tid, lane, wave);
        pg8::gemm_phase(lds, g, S, E);
        if (!(blockIdx.x & 1)) for (int tile = blockIdx.x; tile < 256; tile += G) tail_gemm(lds, ACT + (size_t)MP * FF, FF, (const bf16_t*)(ws + WS_W2B), FF, FF, tile, E, tid, lane, wave);
    }
#undef IN
#undef SEAM
}

#ifndef PROBE_CUT
#define PROBE_CUT -1
#endif
#ifndef PROBE_REP
#define PROBE_REP 0
#endif
extern "C" void kernel_launch(void* const* d_in, const int* in_sizes, int n_in, void* d_out, int out_size, void* d_ws, size_t ws_size, hipStream_t stream) {
    static int grid = 0;
    if (grid == 0) {
        if (n_in != 32 || ws_size < WS_END) { fprintf(stderr, "kernel_launch: unexpected n_in %d / ws_size %zu\n", n_in, ws_size); grid = -1; return; }
        int dev = 0, cus = 0, per_cu = 0;
        hipGetDevice(&dev); hipDeviceGetAttribute(&cus, hipDeviceAttributeMultiprocessorCount, dev);
        hipFuncSetAttribute((const void*)fwd_kernel, hipFuncAttributeMaxDynamicSharedMemorySize, LDS_BYTES);
        hipOccupancyMaxActiveBlocksPerMultiprocessor(&per_cu, (const void*)fwd_kernel, 512, LDS_BYTES);
        (void)hipGetLastError();
        if (per_cu < 1) per_cu = 1;
        grid = cus * 1;
    }
    if (grid < 0) return;
    Args a{};
    for (int i = 0; i < 32; ++i) a.in[i] = (const float*)d_in[i];
    a.out = (float*)d_out; a.ws = (unsigned char*)d_ws;
    (void)hipMemsetAsync((char*)d_ws + WS_BAR, 0, BAR_BYTES, stream);
#if PROBE_CUT >= 0
    { a.ph_lo = 0; a.ph_hi = PROBE_CUT + PROBE_REP; void* args[] = {&a};
      hipLaunchCooperativeKernel((const void*)fwd_kernel, dim3(grid), dim3(512), args, LDS_BYTES, stream); }
    (void)hipMemsetAsync((char*)d_ws + WS_BAR, 0, BAR_BYTES, stream);
    { a.ph_lo = PROBE_CUT; a.ph_hi = 11; void* args[] = {&a};
      hipLaunchCooperativeKernel((const void*)fwd_kernel, dim3(grid), dim3(512), args, LDS_BYTES, stream); }
#else
    a.ph_lo = 0; a.ph_hi = 11; void* args[] = {&a};
    hipError_t e = hipLaunchCooperativeKernel((const void*)fwd_kernel, dim3(grid), dim3(512), args, LDS_BYTES, stream);
    if (e != hipSuccess) fprintf(stderr, "cooperative launch failed: %s (grid %d)\n", hipGetErrorString(e), grid);
#endif
}
```
